# Optimizing an MI355X kernel written in HIP

```python
import math
import jax, jax.numpy as jnp
from jax import lax
import numpy as np

D_MODEL = 2048
BATCH = 16
SEQ = 256
DEPTH = 1
DEC_BATCH = 8
DEC_SEQ = 2048
PAST_LEN = 512

GRID_W = 64
D_ATTN = D_MODEL // 2
N_HEADS = 8
HEAD_DIM = 64
D_POOL = D_MODEL - D_ATTN
POOL_WINDOWS = (2, 4, 8, 16)
N_POOL_GROUPS = 4
POOL_GROUP_DIM = D_POOL // N_POOL_GROUPS
D_IN = 3 * D_ATTN + D_POOL
D_FF = 5504
CONV_W = 3
ROT_AXIS = HEAD_DIM // 2
ROPE_BASE = 10000.0
Q_BLOCK = 128
N_MOD = 6
EPS = 1e-6

kernel_name = "hymba_diffattn_pool_convffn_prefix_dit"


def _rmsnorm(x, g):
    xf = x.astype(jnp.float32)
    y = xf * lax.rsqrt(jnp.mean(xf * xf, axis=-1, keepdims=True) + EPS)
    return (y * g.astype(jnp.float32)).astype(x.dtype)


def _adaln(cond, w, b):
    m = jax.nn.silu(cond) @ w + b
    return jnp.split(m[:, None, :], N_MOD, axis=-1)


def _in_proj(h, w_in):
    B, T = h.shape[0], h.shape[1]
    z = h @ w_in
    q, k, v, p = jnp.split(z, [D_ATTN, 2 * D_ATTN, 3 * D_ATTN], axis=-1)
    q = q.reshape(B, T, N_HEADS, 2, HEAD_DIM)
    k = k.reshape(B, T, N_HEADS, 2, HEAD_DIM)
    v = v.reshape(B, T, N_HEADS, 2 * HEAD_DIM)
    return q, k, v, p


def _lambda(lq1, lk1, lq2, lk2, lam_init):
    s1 = jnp.sum(lq1.astype(jnp.float32) * lk1.astype(jnp.float32))
    s2 = jnp.sum(lq2.astype(jnp.float32) * lk2.astype(jnp.float32))
    return jnp.exp(s1) - jnp.exp(s2) + lam_init


def _diff_core(q, k, v, lam):
    s = jnp.einsum("bqhmd,bkhmd->bhmqk", q, k, preferred_element_type=jnp.float32) * (HEAD_DIM ** -0.5)
    p = jax.nn.softmax(s, axis=-1)
    a = p[:, :, 0] - lam * p[:, :, 1]
    return jnp.einsum("bhqk,bkhe->bqhe", a.astype(v.dtype), v)


def _blocked_diff_attn(q, k_all, v_all, lam):
    B, T = q.shape[0], q.shape[1]
    nb = T // Q_BLOCK
    qb = q.reshape(B, nb, Q_BLOCK, N_HEADS, 2, HEAD_DIM).transpose(1, 0, 2, 3, 4, 5)
    ob = lax.map(lambda qq: _diff_core(qq, k_all, v_all, lam), qb)
    return ob.transpose(1, 0, 2, 3, 4).reshape(B, T, N_HEADS, 2 * HEAD_DIM)


def _axial_rope_tables(rows):
    row = jnp.repeat(jnp.arange(rows), GRID_W).astype(jnp.float32)
    col = jnp.tile(jnp.arange(GRID_W), rows).astype(jnp.float32)
    inv = 1.0 / (ROPE_BASE ** (jnp.arange(0, ROT_AXIS, 2, dtype=jnp.float32) / ROT_AXIS))
    ar = row[:, None] * inv
    ac = col[:, None] * inv
    ang = jnp.concatenate([ar, ar, ac, ac], axis=-1)
    return jnp.cos(ang), jnp.sin(ang)


def _rope(x, cos, sin):
    xr = x.reshape(*x.shape[:-1], 2, 2, ROT_AXIS // 2)
    rot = jnp.stack([-xr[..., 1, :], xr[..., 0, :]], axis=-2).reshape(x.shape)
    c = cos[None, :, None, None, :]
    s = sin[None, :, None, None, :]
    return (x.astype(jnp.float32) * c + rot.astype(jnp.float32) * s).astype(x.dtype)


def _centred_pool_minus_x(p, w):
    B, T, C = p.shape
    pf = p.astype(jnp.float32)
    S = jnp.concatenate([jnp.zeros((B, 1, C), jnp.float32), jnp.cumsum(pf, axis=1)], axis=1)
    t = jnp.arange(T)
    lo = jnp.clip(t - w // 2, 0, T)
    hi = jnp.clip(t + w - w // 2, 0, T)
    cnt = (hi - lo).astype(jnp.float32)
    mean = (S[:, hi] - S[:, lo]) / cnt[None, :, None]
    return (mean - pf).astype(p.dtype)


def _pool_mixer(p, w_pool, pool_scale):
    B, T = p.shape[0], p.shape[1]
    pg = p.reshape(B, T, N_POOL_GROUPS, POOL_GROUP_DIM)
    pooled = jnp.stack([_centred_pool_minus_x(pg[:, :, g], w) for g, w in enumerate(POOL_WINDOWS)], axis=2)
    out = jnp.einsum("btgc,gcd->btgd", pooled, w_pool)
    return out.reshape(B, T, D_POOL) * pool_scale


def _conv_ffn(h, w_up, conv_k, conv_b, w_down):
    T = h.shape[1]
    u = h @ w_up
    up = jnp.pad(u, ((0, 0), (1, 1), (0, 0)))
    u = up[:, :T] * conv_k[0] + up[:, 1:T + 1] * conv_k[1] + up[:, 2:] * conv_k[2] + conv_b
    gate, val = jnp.split(u, 2, axis=-1)
    return (jax.nn.silu(gate) * val) @ w_down


def _layer(x, cond, attend, w_ada, b_ada, norm1_g, w_in, subln_g, lam_init,
           w_pool, pool_scale, w_out, norm2_g, w_up, conv_k, conv_b, w_down):
    B, T = x.shape[0], x.shape[1]
    sh1, sc1, g1, sh2, sc2, g2 = _adaln(cond, w_ada, b_ada)
    h = _rmsnorm(x, norm1_g) * (1.0 + sc1) + sh1
    q, k, v, p = _in_proj(h, w_in)
    a = attend(q, k, v)
    a = (_rmsnorm(a, subln_g) * (1.0 - lam_init)).reshape(B, T, D_ATTN)
    m = _pool_mixer(p, w_pool, pool_scale)
    x = x + g1 * (jnp.concatenate([a, m], axis=-1) @ w_out)
    h2 = _rmsnorm(x, norm2_g) * (1.0 + sc2) + sh2
    x = x + g2 * _conv_ffn(h2, w_up, conv_k, conv_b, w_down)
    return x, k, v


def setup_inputs(seed: int = 0) -> dict:
    key = jax.random.key(seed)
    ks = jax.random.split(key, 26)
    f32 = jnp.float32
    nrm = lambda k, shape, s: jax.random.normal(k, shape, f32) * s
    return {
        "x_prompt": nrm(ks[0], (BATCH, SEQ, D_MODEL), 1.0),
        "x_sample": nrm(ks[1], (DEC_BATCH, DEC_SEQ, D_MODEL), 1.0),
        "c": nrm(ks[2], (DEC_BATCH, D_MODEL), 1.0),
        "cache_k": nrm(ks[3], (DEC_BATCH, DEPTH, PAST_LEN, N_HEADS, 2 * HEAD_DIM), 1.0),
        "cache_v": nrm(ks[4], (DEC_BATCH, DEPTH, PAST_LEN, N_HEADS, 2 * HEAD_DIM), 1.0),
        "c_ctx": nrm(ks[5], (D_MODEL,), 1.0),
        "w_ada": nrm(ks[6], (DEPTH, D_MODEL, N_MOD * D_MODEL), 0.5 * D_MODEL ** -0.5),
        "b_ada": nrm(ks[7], (DEPTH, N_MOD * D_MODEL), 0.01),
        "norm1_g": 1.0 + nrm(ks[8], (DEPTH, D_MODEL), 0.01),
        "w_in": nrm(ks[9], (DEPTH, D_MODEL, D_IN), D_MODEL ** -0.5),
        "lam_q1": nrm(ks[10], (DEPTH, HEAD_DIM), 0.1),
        "lam_k1": nrm(ks[11], (DEPTH, HEAD_DIM), 0.1),
        "lam_q2": nrm(ks[12], (DEPTH, HEAD_DIM), 0.1),
        "lam_k2": nrm(ks[13], (DEPTH, HEAD_DIM), 0.1),
        "subln_g": 1.0 + nrm(ks[14], (DEPTH, 2 * HEAD_DIM), 0.01),
        "w_pool": nrm(ks[15], (DEPTH, N_POOL_GROUPS, POOL_GROUP_DIM, POOL_GROUP_DIM), POOL_GROUP_DIM ** -0.5),
        "pool_scale": 1.0 + nrm(ks[16], (DEPTH, D_POOL), 0.1),
        "w_out": nrm(ks[17], (DEPTH, D_MODEL, D_MODEL), D_MODEL ** -0.5),
        "norm2_g": 1.0 + nrm(ks[18], (DEPTH, D_MODEL), 0.01),
        "w_up": nrm(ks[19], (DEPTH, D_MODEL, 2 * D_FF), D_MODEL ** -0.5),
        "conv_k": nrm(ks[20], (DEPTH, CONV_W, 2 * D_FF), CONV_W ** -0.5),
        "conv_b": nrm(ks[21], (DEPTH, 2 * D_FF), 0.01),
        "w_down": nrm(ks[22], (DEPTH, D_FF, D_MODEL), D_FF ** -0.5),
        "norm_f_g": 1.0 + nrm(ks[23], (D_MODEL,), 0.01),
    }


def reference(x_prompt, x_sample, c, cache_k, cache_v, c_ctx, w_ada, b_ada, norm1_g, w_in,
              lam_q1, lam_k1, lam_q2, lam_k2, subln_g, w_pool, pool_scale, w_out, norm2_g,
              w_up, conv_k, conv_b, w_down, norm_f_g):
    xc = x_prompt
    Bc, Lc = xc.shape[0], xc.shape[1]
    ks_new, vs_new = [], []
    for l in range(DEPTH):
        lam_init = 0.8 - 0.6 * math.exp(-0.3 * l)
        lam = _lambda(lam_q1[l], lam_k1[l], lam_q2[l], lam_k2[l], lam_init)
        attend_ctx = lambda q, k, v, lam=lam: _diff_core(q, k, v, lam)
        xc, k, v = _layer(xc, c_ctx[None, :], attend_ctx, w_ada[l], b_ada[l], norm1_g[l], w_in[l],
                          subln_g[l], lam_init, w_pool[l], pool_scale[l], w_out[l], norm2_g[l],
                          w_up[l], conv_k[l], conv_b[l], w_down[l])
        ks_new.append(k.reshape(Bc, Lc, N_HEADS, 2 * HEAD_DIM))
        vs_new.append(v)
    y_prompt = _rmsnorm(xc, norm_f_g)
    state_k = jnp.stack(ks_new, axis=1)
    state_v = jnp.stack(vs_new, axis=1)

    xs = x_sample
    T = xs.shape[1]
    rows = T // GRID_W
    cos, sin = _axial_rope_tables(rows)
    for l in range(DEPTH):
        lam_init = 0.8 - 0.6 * math.exp(-0.3 * l)
        lam = _lambda(lam_q1[l], lam_k1[l], lam_q2[l], lam_k2[l], lam_init)
        kc = cache_k[:, l]
        vc = cache_v[:, l]

        def attend_lat(q, k, v, kc=kc, vc=vc, lam=lam):
            q = _rope(q, cos, sin)
            k = _rope(k, cos, sin)
            kc5 = kc.reshape(kc.shape[0], kc.shape[1], N_HEADS, 2, HEAD_DIM)
            k_all = jnp.concatenate([kc5, k], axis=1)
            v_all = jnp.concatenate([vc, v], axis=1)
            return _blocked_diff_attn(q, k_all, v_all, lam)

        xs, _, _ = _layer(xs, c, attend_lat, w_ada[l], b_ada[l], norm1_g[l], w_in[l],
                          subln_g[l], lam_init, w_pool[l], pool_scale[l], w_out[l], norm2_g[l],
                          w_up[l], conv_k[l], conv_b[l], w_down[l])
    y_sample = _rmsnorm(xs, norm_f_g)
    return (y_prompt, y_sample, state_k, state_v)
```

```cpp
#include <hip/hip_runtime.h>
#include <hip/hip_cooperative_groups.h>
#include <cstdio>
#include <cstdint>
namespace cg = cooperative_groups;
#ifndef PH0
#define PH0 1
#endif
#ifndef PH1
#define PH1 1
#endif
#ifndef PH2
#define PH2 1
#endif
#ifndef PH3
#define PH3 1
#endif
#ifndef PH3B
#define PH3B 1
#endif
#ifndef PH4
#define PH4 1
#endif
#ifndef PH5
#define PH5 1
#endif
#ifndef PH6
#define PH6 1
#endif
#ifndef PH7
#define PH7 1
#endif
#ifndef PH8
#define PH8 1
#endif
#ifndef PH9
#define PH9 1
#endif

constexpr int DM = 2048, NCTX = 4096, NLAT = 16384, MROWS = 20480, DIN = 4096, DFF = 5504, NUP = 11008, DATT = 1024;
constexpr int TCTX = 256, TLAT = 2048, PAST = 512, TALL = 2560, NMOD = 12288;
constexpr float EPS = 1e-6f;
constexpr float QSCALE = 0.125f * 1.4426950408889634f;
namespace pg8 {
#define PG8_LAS __attribute__((address_space(3)))
typedef unsigned short bf16_t;
typedef short bf16x8 __attribute__((ext_vector_type(8)));
typedef float f32x4 __attribute__((ext_vector_type(4)));
typedef unsigned u32x4 __attribute__((ext_vector_type(4)));
constexpr int BM = 256, BK = 64, HALF = 128, HTB = HALF * BK * 2  , STAGE_BYTES = 8 * HTB, NXCD = 8, WGM = 4;

__host__ __device__ __forceinline__ int lds_byte(int r, int c) { const int st = (r >> 4) * 2 + (c >> 5), rr = r & 15, cc = c & 31, ob = rr * 64 + cc * 2; return st * 1024 + (ob ^ (((ob >> 9) & 1) << 5)); }
__host__ __device__ __forceinline__ void stage_rc(int b, int& R, int& C) { const int st = b / 1024, sb = b % 1024, swz = sb ^ (((sb >> 9) & 1) << 5); R = (st >> 1) * 16 + swz / 64; C = (st & 1) * 32 + (swz % 64) / 2; }
__host__ __device__ __forceinline__ int perm32(int rho) { const int n = rho >> 4, i = rho & 15; return 8 * (i >> 2) + 4 * n + (i & 3); }

struct Unit { int pm, pn; };
struct Gemm { const bf16_t* A; const bf16_t* Bt; int lda, ldb, K, acol; };

struct StaticOrder {
    int nM, nN, nwg, G, c;
    __host__ __device__ void init(int M, int N, int G_, int c_) { nM = M / BM; nN = N / BM; nwg = nM * nN; G = G_; c = c_; }
    __host__ __device__ bool next(int i, Unit& u) const {
        const long L = (long)i * G + c; if (L >= nwg) return false;
        int wgid = (int)L; { const int q = nwg / NXCD, r = nwg % NXCD, xcd = wgid % NXCD, off = wgid / NXCD; wgid = (xcd < r ? xcd * (q + 1) : r * (q + 1) + (xcd - r) * q) + off; }
        const int nig = WGM * nN, gid = wgid / nig, fm = gid * WGM, gsz = (nM - fm) < WGM ? (nM - fm) : WGM;
        u.pm = fm + ((wgid % nig) % gsz); u.pn = (wgid % nig) / gsz; return true;
    }
    __device__ __forceinline__ void a_ready(const Unit&) const {}
    __device__ __forceinline__ void done(const Unit&) const {}
};

struct PanelOrder {
    StaticOrder so; bool fast;
    __host__ __device__ void init(int M, int N, int G_, int c_) { so.init(M, N, G_, c_); fast = (G_ == 256 && so.nN == 8 && so.nM == 80); }
    __host__ __device__ bool next(int i, Unit& u) const {
        if (!fast) return so.next(i, u);
        const int c = so.c, xcd = c & 7, j = c >> 3;
        if (i < 2) { u.pm = i * 32 + xcd * 4 + (j & 3); u.pn = j >> 2; return true; }
        if (i == 2 && c < 128) { u.pm = 64 + xcd * 2 + (j & 1); u.pn = j >> 1; return true; }
        return false;
    }
    __device__ __forceinline__ void a_ready(const Unit&) const {}
    __device__ __forceinline__ void done(const Unit&) const {}
};

struct NoMid { __device__ __forceinline__ void operator()(int) const {} };
template <class Epi, class Sched, bool ALIGN_EPI = false, bool SP2 = false, class Mid = NoMid>
__device__ __forceinline__ void gemm_phase(PG8_LAS unsigned char* lds, const Gemm g, const Sched& S, const Epi& E, const Mid& MH = Mid()) {
    int tid_ = threadIdx.x; asm volatile("" : "+v"(tid_));
    const int tid = tid_, wid = __builtin_amdgcn_readfirstlane(tid >> 6), lane = tid & 63, wr = wid >> 2, wc = wid & 3, fr = lane & 15, fq = lane >> 4;
    const int K = g.K, nt = K / BK;
    unsigned voffA[2], voffB[2];
#pragma unroll
    for (int i = 0; i < 2; ++i) { int R, C; stage_rc(tid * 16 + i * 8192, R, C); const int Rb = Epi::PERM ? ((R & ~31) + perm32(R & 31)) : R;
        voffA[i] = (unsigned)(R * g.lda + C) * 2u; voffB[i] = (unsigned)(Rb * g.ldb + C) * 2u; }
    const size_t kstep = (size_t)(BK * 2);
    const size_t hstepA = (size_t)HALF * g.lda * 2, hstepB = (size_t)HALF * g.ldb * 2;
    const size_t tstepA = 2 * hstepA, tstepB = 2 * hstepB, acolb = (size_t)g.acol * 2;
    const unsigned ldsw = (unsigned)wid * 1024u;
    const int aoff = lds_byte(wr * 64 + fr, fq * 8), boff = lds_byte(wc * 32 + fr, fq * 8);
#define PG8_SA(b, h) (((b) * 2 + (h)) * HTB)
#define PG8_SB(b, h) ((4 + (b) * 2 + (h)) * HTB)
#define PG8_STAGE(bufoff, gbase, voff) do { _Pragma("unroll") for (int _i = 0; _i < 2; ++_i) \
        __builtin_amdgcn_global_load_lds((const unsigned*)((const char*)(gbase) + (voff)[_i]), (PG8_LAS unsigned*)(lds + (bufoff) + ldsw + _i * 8192), 16, 0, 0); } while (0)
#define PG8_LDA(dst, b, h) do { _Pragma("unroll") for (int m = 0; m < 4; ++m) _Pragma("unroll") for (int k = 0; k < 2; ++k) dst[m][k] = *(const PG8_LAS bf16x8*)(lds + PG8_SA(b, h) + aoff + m * 2048 + k * 1024); } while (0)
#define PG8_LDB(dst, b, h) do { _Pragma("unroll") for (int n = 0; n < 2; ++n) _Pragma("unroll") for (int k = 0; k < 2; ++k) dst[n][k] = *(const PG8_LAS bf16x8*)(lds + PG8_SB(b, h) + boff + n * 2048 + k * 1024); } while (0)
#define PG8_MMA(ai, bj, At, Bt) do { __builtin_amdgcn_s_setprio(1); _Pragma("unroll") for (int m = 0; m < 4; ++m) _Pragma("unroll") for (int n = 0; n < 2; ++n) _Pragma("unroll") for (int k = 0; k < 2; ++k) \
        acc[ai][bj][m][n] = __builtin_amdgcn_mfma_f32_16x16x32_bf16(Bt[n][k], At[m][k], acc[ai][bj][m][n], 0, 0, 0); __builtin_amdgcn_s_setprio(0); } while (0)
#define PG8_WAIT_V(n) asm volatile("s_waitcnt vmcnt(" #n ")" ::: "memory")
#define PG8_WAIT_L(n) asm volatile("s_waitcnt lgkmcnt(" #n ")" ::: "memory")
#define PG8_BAR __builtin_amdgcn_s_barrier()
#define PG8_SCHED __builtin_amdgcn_sched_barrier(0)
    Unit cur, nxt; int ui = 0;
    if (!S.next(0, cur)) return;
    f32x4 acc[2][2][4][2];
#pragma unroll
    for (int a = 0; a < 2; ++a)
#pragma unroll
        for (int b = 0; b < 2; ++b)
#pragma unroll
            for (int m = 0; m < 4; ++m)
#pragma unroll
                for (int n = 0; n < 2; ++n) acc[a][b][m][n] = (f32x4){0.f, 0.f, 0.f, 0.f};
    bf16x8 At[4][2], B0[2][2], B1[2][2];
    const char* cA = (const char*)g.A + (size_t)cur.pm * tstepA + (size_t)cur.pn * acolb; const char* cB = (const char*)g.Bt + (size_t)cur.pn * tstepB;
    S.a_ready(cur);
    if constexpr (SP2) {
        PG8_STAGE(PG8_SB(0, 0), cB, voffB); PG8_STAGE(PG8_SB(0, 1), cB + hstepB, voffB); PG8_STAGE(PG8_SA(0, 0), cA, voffA); PG8_STAGE(PG8_SA(0, 1), cA + hstepA, voffA);
        if (wr == 1) PG8_BAR;
        PG8_WAIT_V(2); PG8_BAR;
        PG8_STAGE(PG8_SB(1, 0), cB + kstep, voffB); PG8_STAGE(PG8_SA(1, 0), cA + kstep, voffA); PG8_STAGE(PG8_SB(1, 1), cB + hstepB + kstep, voffB);
        PG8_WAIT_V(6); PG8_BAR;
    } else {
        PG8_STAGE(PG8_SB(0, 0), cB, voffB); PG8_STAGE(PG8_SA(0, 0), cA, voffA); PG8_STAGE(PG8_SB(0, 1), cB + hstepB, voffB); PG8_STAGE(PG8_SA(0, 1), cA + hstepA, voffA);
        if (wr == 1) PG8_BAR;
        PG8_WAIT_V(4); PG8_BAR;
        PG8_STAGE(PG8_SB(1, 0), cB + kstep, voffB); PG8_STAGE(PG8_SA(1, 0), cA + kstep, voffA); PG8_STAGE(PG8_SB(1, 1), cB + hstepB + kstep, voffB);
        PG8_WAIT_V(6); PG8_BAR;
    }
    for (;;) {
        const bool has_next = S.next(ui + 1, nxt);
        const char* nA = has_next ? (const char*)g.A + (size_t)nxt.pm * tstepA + (size_t)nxt.pn * acolb : cA; const char* nB = has_next ? (const char*)g.Bt + (size_t)nxt.pn * tstepB : cB;
        for (int t = 0; t < nt; t += 2) {
            const bool last = (t == nt - 2);
            const char* a1 = cA + (size_t)(t + 1) * kstep;
            const char* a2 = last ? nA : cA + (size_t)(t + 2) * kstep; const char* b2 = last ? nB : cB + (size_t)(t + 2) * kstep;
            const char* a3 = a2 + kstep; const char* b3 = b2 + kstep;
            if (last && has_next) S.a_ready(nxt);
            if constexpr (SP2) {
            PG8_LDB(B0, 0, 0); PG8_LDB(B1, 0, 1); PG8_SCHED; PG8_LDA(At, 0, 0); PG8_STAGE(PG8_SA(1, 1), a1 + hstepA, voffA);
            PG8_WAIT_V(8); PG8_WAIT_L(0); PG8_BAR; PG8_MMA(0, 0, At, B0); PG8_MMA(0, 1, At, B1); PG8_BAR; PG8_SCHED;
            PG8_LDA(At, 0, 1); PG8_STAGE(PG8_SB(0, 0), b2, voffB); PG8_STAGE(PG8_SB(0, 1), b2 + hstepB, voffB); PG8_STAGE(PG8_SA(0, 0), a2, voffA);
            PG8_WAIT_V(8); PG8_WAIT_L(0); PG8_BAR; PG8_MMA(1, 0, At, B0); PG8_MMA(1, 1, At, B1); PG8_BAR; PG8_SCHED;
            PG8_LDB(B0, 1, 0); PG8_LDB(B1, 1, 1); PG8_SCHED; PG8_LDA(At, 1, 0); PG8_STAGE(PG8_SA(0, 1), a2 + hstepA, voffA);
            PG8_WAIT_V(8); PG8_WAIT_L(0); PG8_BAR; PG8_MMA(0, 0, At, B0); PG8_MMA(0, 1, At, B1); PG8_BAR; PG8_SCHED;
            PG8_LDA(At, 1, 1); PG8_STAGE(PG8_SB(1, 0), b3, voffB); PG8_STAGE(PG8_SB(1, 1), b3 + hstepB, voffB); PG8_STAGE(PG8_SA(1, 0), a3, voffA);
            PG8_WAIT_V(8); PG8_WAIT_L(0); PG8_BAR; PG8_MMA(1, 0, At, B0); PG8_MMA(1, 1, At, B1); PG8_BAR; PG8_SCHED;
            } else {
            PG8_LDB(B0, 0, 0); PG8_SCHED; PG8_LDA(At, 0, 0); PG8_STAGE(PG8_SA(1, 1), a1 + hstepA, voffA);
            PG8_WAIT_L(8); PG8_BAR; PG8_WAIT_L(0); PG8_MMA(0, 0, At, B0); PG8_BAR; PG8_SCHED;
            PG8_LDB(B1, 0, 1); PG8_STAGE(PG8_SB(0, 0), b2, voffB);
            PG8_BAR; PG8_WAIT_L(0); PG8_MMA(0, 1, At, B1); PG8_BAR;
            PG8_LDA(At, 0, 1); PG8_STAGE(PG8_SA(0, 0), a2, voffA);
            PG8_BAR; PG8_WAIT_L(0); PG8_MMA(1, 0, At, B0); PG8_BAR; PG8_SCHED;
            PG8_STAGE(PG8_SB(0, 1), b2 + hstepB, voffB);
            PG8_WAIT_V(6); PG8_BAR; PG8_MMA(1, 1, At, B1); PG8_BAR;
            PG8_LDB(B0, 1, 0); PG8_SCHED; PG8_LDA(At, 1, 0); PG8_STAGE(PG8_SA(0, 1), a2 + hstepA, voffA);
            PG8_WAIT_L(8); PG8_BAR; PG8_WAIT_L(0); PG8_MMA(0, 0, At, B0); PG8_BAR; PG8_SCHED;
            PG8_LDB(B1, 1, 1); PG8_STAGE(PG8_SB(1, 0), b3, voffB);
            PG8_BAR; PG8_WAIT_L(0); PG8_MMA(0, 1, At, B1); PG8_BAR;
            PG8_LDA(At, 1, 1); PG8_STAGE(PG8_SA(1, 0), a3, voffA);
            PG8_BAR; PG8_WAIT_L(0); PG8_MMA(1, 0, At, B0); PG8_BAR; PG8_SCHED;
            PG8_STAGE(PG8_SB(1, 1), b3 + hstepB, voffB);
            PG8_WAIT_V(6); PG8_BAR; PG8_MMA(1, 1, At, B1); PG8_BAR;
            }
        }
        if constexpr (ALIGN_EPI) { if (wr == 0) PG8_BAR; }
        if constexpr (!Epi::AFTER_DRAIN) { E(acc, cur, wr, wc, fr, fq); S.done(cur); }
        MH(ui);
        if (!has_next) break;
#pragma unroll
        for (int a = 0; a < 2; ++a)
#pragma unroll
            for (int b = 0; b < 2; ++b)
#pragma unroll
                for (int m = 0; m < 4; ++m)
#pragma unroll
                    for (int n = 0; n < 2; ++n) acc[a][b][m][n] = (f32x4){0.f, 0.f, 0.f, 0.f};
        cur = nxt; cA = nA; cB = nB; ++ui;
        if constexpr (ALIGN_EPI) { if (wr == 1) PG8_BAR; }
    }
    PG8_WAIT_V(0);
    if constexpr (!ALIGN_EPI) { if (wr == 0) PG8_BAR; }
    PG8_BAR;
    if constexpr (Epi::AFTER_DRAIN) { E.fused(acc, cur, wr, wc, fr, fq, lds, wid, lane); S.done(cur); }
#undef PG8_SA
#undef PG8_SB
#undef PG8_STAGE
#undef PG8_LDA
#undef PG8_LDB
#undef PG8_MMA
#undef PG8_WAIT_V
#undef PG8_WAIT_L
#undef PG8_BAR
#undef PG8_SCHED
}
typedef float f32x2 __attribute__((ext_vector_type(2)));
typedef __bf16 bf16x2_t __attribute__((ext_vector_type(2)));
typedef unsigned u32x2 __attribute__((ext_vector_type(2)));
__device__ __forceinline__ unsigned cvtpk(float lo, float hi) { f32x2 v = {lo, hi}; bf16x2_t b = __builtin_convertvector(v, bf16x2_t); return __builtin_bit_cast(unsigned, b); }
__device__ __forceinline__ u32x2 pack4(f32x4 v) { u32x2 w; w.x = cvtpk(v[0], v[1]); w.y = cvtpk(v[2], v[3]); return w; }
__device__ __forceinline__ unsigned short bf1(float v) { return (unsigned short)(cvtpk(v, 0.f) & 0xffffu); }

struct EpiInProj {
    static constexpr bool PERM = false, AFTER_DRAIN = false;
    bf16_t *Q, *Kc, *Kl, *Vtc, *Vtl, *P; float *sk, *sv; const float* rope;
    __device__ __forceinline__ void operator()(const f32x4 (&acc)[2][2][4][2], const Unit& u, int wr, int wc, int fr, int fq) const {
        const int kind = u.pn >> 2; const bool lat = u.pm >= 16; const int pml = u.pm - 16;
        const int b = lat ? (pml >> 3) : u.pm; const int t0 = lat ? (pml & 7) * 256 : 0; const int cb = (u.pn & 3) * 256;
#pragma unroll
        for (int ai = 0; ai < 2; ++ai)
#pragma unroll
            for (int m = 0; m < 4; ++m) {
                const int tl = ai * HALF + wr * 64 + m * 16 + fr; const int t = t0 + tl; const size_t row = (size_t)u.pm * BM + tl;
                f32x4 c0v = {1.f, 1.f, 1.f, 1.f}, s0v = {0.f, 0.f, 0.f, 0.f};
                if (kind <= 1 && lat) { const int pos = (wc & 1) ? (t & 63) : (t >> 6); const f32x4* rp = (const f32x4*)(rope + (pos * 16 + fq * 4) * 2);
                    const f32x4 a = rp[0], bq = rp[1]; c0v = (f32x4){a[0], a[2], bq[0], bq[2]}; s0v = (f32x4){a[1], a[3], bq[1], bq[3]}; }
#pragma unroll
                for (int bj = 0; bj < 2; ++bj) {
                    f32x4 v0 = acc[ai][bj][m][0], v1 = acc[ai][bj][m][1];
                    const int c0 = cb + bj * HALF + wc * 32 + fq * 4;
                    if (kind <= 1 && lat) { const f32x4 r0 = v0 * c0v - v1 * s0v, r1 = v1 * c0v + v0 * s0v; v0 = r0; v1 = r1; }
                    if (kind == 0) { v0 = v0 * QSCALE; v1 = v1 * QSCALE; bf16_t* o = Q + row * DATT + c0; *(u32x2*)o = pack4(v0); *(u32x2*)(o + 16) = pack4(v1); }
                    else if (kind == 1) {
                        if (!lat) { float* so = sk + row * DATT + c0; *(f32x4*)so = v0; *(f32x4*)(so + 16) = v1; bf16_t* o = Kc + row * DATT + c0; *(u32x2*)o = pack4(v0); *(u32x2*)(o + 16) = pack4(v1); }
                        else { bf16_t* o = Kl + ((size_t)b * TALL + PAST + t) * DATT + c0; *(u32x2*)o = pack4(v0); *(u32x2*)(o + 16) = pack4(v1); }
                    } else if (kind == 2) {
                        const int head = (u.pn & 3) * 2 + bj, dcol = wc * 32 + fq * 4;
                        if (!lat) { float* so = sv + row * DATT + c0; *(f32x4*)so = v0; *(f32x4*)(so + 16) = v1;
                            bf16_t* o = Vtc + ((size_t)(b * 8 + head) * 128 + dcol) * TCTX + t;
#pragma unroll
                            for (int i = 0; i < 4; ++i) { o[(size_t)i * TCTX] = bf1(v0[i]); o[(size_t)(i + 16) * TCTX] = bf1(v1[i]); } }
                        else { bf16_t* o = Vtl + ((size_t)(b * 8 + head) * 128 + dcol) * TALL + PAST + t;
#pragma unroll
                            for (int i = 0; i < 4; ++i) { o[(size_t)i * TALL] = bf1(v0[i]); o[(size_t)(i + 16) * TALL] = bf1(v1[i]); } }
                    } else { bf16_t* o = P + row * DATT + c0; *(u32x2*)o = pack4(v0); *(u32x2*)(o + 16) = pack4(v1); }
                }
            }
    }
};
struct EpiResid {
    static constexpr bool PERM = false, AFTER_DRAIN = false;
    const float *xa, *xb; float* out; const float* gate;
    __device__ __forceinline__ void operator()(const f32x4 (&acc)[2][2][4][2], const Unit& u, int wr, int wc, int fr, int fq) const {
        const int bidx = u.pm < 16 ? 8 : ((u.pm - 16) >> 3);
        const float* gp = gate + (size_t)bidx * NMOD + u.pn * BM + wc * 32 + fq * 4;
        f32x4 gv[2][2];
#pragma unroll
        for (int bj = 0; bj < 2; ++bj)
#pragma unroll
            for (int n = 0; n < 2; ++n) gv[bj][n] = *(const f32x4*)(gp + bj * HALF + n * 16);
#pragma unroll
        for (int ai = 0; ai < 2; ++ai)
#pragma unroll
            for (int m = 0; m < 4; ++m) {
                const size_t row = (size_t)u.pm * BM + ai * HALF + wr * 64 + m * 16 + fr;
                const float* xr = (row < (size_t)NCTX ? xa + row * DM : xb + (row - NCTX) * DM) + u.pn * BM + wc * 32 + fq * 4;
                float* orow = out + row * DM + u.pn * BM + wc * 32 + fq * 4;
#pragma unroll
                for (int bj = 0; bj < 2; ++bj)
#pragma unroll
                    for (int n = 0; n < 2; ++n) { const f32x4 xv = *(const f32x4*)(xr + bj * HALF + n * 16); *(f32x4*)(orow + bj * HALF + n * 16) = xv + gv[bj][n] * acc[ai][bj][m][n]; }
            }
    }
};
struct EpiGateBf16 {
    static constexpr bool PERM = false, AFTER_DRAIN = false;
    bf16_t* dst; const float* gate;
    __device__ __forceinline__ void operator()(const f32x4 (&acc)[2][2][4][2], const Unit& u, int wr, int wc, int fr, int fq) const {
        const int bidx = u.pm < 16 ? 8 : ((u.pm - 16) >> 3);
        const int cofs = u.pn * BM + wc * 32 + fq * 4;
        const float* gp = gate + (size_t)bidx * NMOD + cofs;
        bf16_t* o0 = dst + ((size_t)u.pm * BM + wr * 64 + fr) * DM + cofs;
#pragma unroll
        for (int bj = 0; bj < 2; ++bj)
#pragma unroll
            for (int n = 0; n < 2; ++n) {
                const f32x4 gv = *(const f32x4*)(gp + bj * HALF + n * 16);
#pragma unroll
                for (int ai = 0; ai < 2; ++ai)
#pragma unroll
                    for (int m = 0; m < 4; ++m) *(u32x2*)(o0 + (size_t)(ai * HALF + m * 16) * DM + bj * HALF + n * 16) = pack4(acc[ai][bj][m][n] * gv);
            }
    }
};
struct EpiPool {
    static constexpr bool PERM = false, AFTER_DRAIN = false;
    bf16_t* am; const float* scale;
    __device__ __forceinline__ void operator()(const f32x4 (&acc)[2][2][4][2], const Unit& u, int wr, int wc, int fr, int fq) const {
        const int cbase = u.pn * BM + wc * 32 + fq * 4;
        bf16_t* o0 = am + ((size_t)u.pm * BM + wr * 64 + fr) * DM + DATT + cbase;
#pragma unroll
        for (int bj = 0; bj < 2; ++bj)
#pragma unroll
            for (int n = 0; n < 2; ++n) {
                const f32x4 sv = *(const f32x4*)(scale + cbase + bj * HALF + n * 16);
#pragma unroll
                for (int ai = 0; ai < 2; ++ai)
#pragma unroll
                    for (int m = 0; m < 4; ++m) *(u32x2*)(o0 + (size_t)(ai * HALF + m * 16) * DM + bj * HALF + n * 16) = pack4(acc[ai][bj][m][n] * sv);
            }
    }
};
#define DPP_F(v, ctrl) __builtin_bit_cast(float, __builtin_amdgcn_update_dpp(0, __builtin_bit_cast(int, (v)), (ctrl), 0xf, 0xf, true))
#ifndef USE_DPP
#define USE_DPP 0
#endif
#if USE_DPP
__device__ __forceinline__ f32x4 dpp_shr1(f32x4 v)  { return (f32x4){DPP_F(v[0], 0x111), DPP_F(v[1], 0x111), DPP_F(v[2], 0x111), DPP_F(v[3], 0x111)}; }
__device__ __forceinline__ f32x4 dpp_shl1(f32x4 v)  { return (f32x4){DPP_F(v[0], 0x101), DPP_F(v[1], 0x101), DPP_F(v[2], 0x101), DPP_F(v[3], 0x101)}; }
__device__ __forceinline__ f32x4 dpp_shl15(f32x4 v) { return (f32x4){DPP_F(v[0], 0x10F), DPP_F(v[1], 0x10F), DPP_F(v[2], 0x10F), DPP_F(v[3], 0x10F)}; }
__device__ __forceinline__ f32x4 dpp_shr15(f32x4 v) { return (f32x4){DPP_F(v[0], 0x11F), DPP_F(v[1], 0x11F), DPP_F(v[2], 0x11F), DPP_F(v[3], 0x11F)}; }
#else
__device__ __forceinline__ f32x4 shfl_sel(f32x4 v, int src, bool ok) { f32x4 o;
#pragma unroll
    for (int i = 0; i < 4; ++i) { const float t = __shfl(v[i], src); o[i] = ok ? t : 0.f; } return o; }
__device__ __forceinline__ f32x4 dpp_shr1(f32x4 v)  { const int l = threadIdx.x & 63; return shfl_sel(v, l - 1, (l & 15) != 0); }
__device__ __forceinline__ f32x4 dpp_shl1(f32x4 v)  { const int l = threadIdx.x & 63; return shfl_sel(v, l + 1, (l & 15) != 15); }
__device__ __forceinline__ f32x4 dpp_shl15(f32x4 v) { const int l = threadIdx.x & 63; return shfl_sel(v, l + 15, (l & 15) == 0); }
__device__ __forceinline__ f32x4 dpp_shr15(f32x4 v) { const int l = threadIdx.x & 63; return shfl_sel(v, l - 15, (l & 15) == 15); }
#endif
__device__ __forceinline__ f32x4 silu_mul(f32x4 g, f32x4 v) {
    f32x4 o;
#pragma unroll
    for (int i = 0; i < 4; ++i) { const float e = __builtin_amdgcn_exp2f(-g[i] * 1.4426950408889634f); o[i] = g[i] * __builtin_amdgcn_rcpf(1.0f + e) * v[i]; }
    return o;
}
struct EpiUp {
    static constexpr bool PERM = false, AFTER_DRAIN = false;
    bf16_t* act; float* ebuf; const float* ck; const float* cbias; PG8_LAS float* xl;
    __device__ __forceinline__ void operator()(const f32x4 (&acc)[2][2][4][2], const Unit& u, int wr, int wc, int fr, int fq) const {
        const int colw = wc * 32 + fq * 4;
#pragma unroll
        for (int ai = 0; ai < 2; ++ai)
#pragma unroll
            for (int bj = 0; bj < 2; ++bj)
#pragma unroll
                for (int n = 0; n < 2; ++n) { const int col = bj * HALF + n * 16 + colw, rb = ai * 2 + wr;
                    if (fr == 0) *(PG8_LAS f32x4*)(xl + (rb * 2) * 256 + col) = acc[ai][bj][0][n];
                    if (fr == 15) *(PG8_LAS f32x4*)(xl + (rb * 2 + 1) * 256 + col) = acc[ai][bj][3][n]; }
        float* eb = ebuf + (size_t)u.pm * 4 * NUP + u.pn * BM + colw;
        if (wr == 0 && fr < 2) {
#pragma unroll
            for (int bj = 0; bj < 2; ++bj)
#pragma unroll
                for (int n = 0; n < 2; ++n) *(f32x4*)(eb + (size_t)fr * NUP + bj * HALF + n * 16) = acc[0][bj][0][n]; }
        if (wr == 1 && fr >= 14) {
#pragma unroll
            for (int bj = 0; bj < 2; ++bj)
#pragma unroll
                for (int n = 0; n < 2; ++n) *(f32x4*)(eb + (size_t)(fr - 12) * NUP + bj * HALF + n * 16) = acc[1][bj][3][n]; }
        asm volatile("s_waitcnt lgkmcnt(0)" ::: "memory"); __builtin_amdgcn_s_barrier(); asm volatile("" ::: "memory");
#pragma unroll
        for (int n = 0; n < 2; ++n) {
            const int gc = u.pn * HALF + n * 16 + colw;
            const f32x4 k0g = *(const f32x4*)(ck + gc), k1g = *(const f32x4*)(ck + NUP + gc), k2g = *(const f32x4*)(ck + 2 * NUP + gc), bg = *(const f32x4*)(cbias + gc);
            const f32x4 k0v = *(const f32x4*)(ck + DFF + gc), k1v = *(const f32x4*)(ck + NUP + DFF + gc), k2v = *(const f32x4*)(ck + 2 * NUP + DFF + gc), bv = *(const f32x4*)(cbias + DFF + gc);
#pragma unroll
            for (int ai = 0; ai < 2; ++ai) {
                const int rb = ai * 2 + wr; const f32x4 z4 = {0.f, 0.f, 0.f, 0.f};
                const int l_ = threadIdx.x & 63, srcR = (l_ & 48) | ((l_ - 1) & 15), srcL = (l_ & 48) | ((l_ + 1) & 15);
                int Rp[4] = {0, 0, 0, 0}, Lc[4], Ln[4] = {0, 0, 0, 0};
#pragma unroll
                for (int i = 0; i < 4; ++i) Lc[i] = __shfl((int)cvtpk(acc[ai][0][0][n][i], acc[ai][1][0][n][i]), srcL);
#pragma unroll
                for (int m = 0; m < 4; ++m) {
                    const f32x4 cg_ = acc[ai][0][m][n], cv_ = acc[ai][1][m][n];
                    int Rc[4];
#pragma unroll
                    for (int i = 0; i < 4; ++i) Rc[i] = __shfl((int)cvtpk(cg_[i], cv_[i]), srcR);
                    if (m < 3) {
#pragma unroll
                        for (int i = 0; i < 4; ++i) Ln[i] = __shfl((int)cvtpk(acc[ai][0][m < 3 ? m + 1 : 3][n][i], acc[ai][1][m < 3 ? m + 1 : 3][n][i]), srcL); }
                    f32x4 ug, uv, dg, dv;
#pragma unroll
                    for (int i = 0; i < 4; ++i) {
                        const unsigned up = (unsigned)(fr > 0 ? Rc[i] : Rp[i]), dn = (unsigned)(fr < 15 ? Lc[i] : Ln[i]);
                        ug[i] = __builtin_bit_cast(float, up << 16); uv[i] = __builtin_bit_cast(float, up & 0xffff0000u);
                        dg[i] = __builtin_bit_cast(float, dn << 16); dv[i] = __builtin_bit_cast(float, dn & 0xffff0000u);
                        Rp[i] = Rc[i]; Lc[i] = Ln[i];
                    }
                    if (m == 0 && fr == 0) { ug = z4; uv = z4; if (rb > 0) { ug = *(const PG8_LAS f32x4*)(xl + ((rb - 1) * 2 + 1) * 256 + n * 16 + colw); uv = *(const PG8_LAS f32x4*)(xl + ((rb - 1) * 2 + 1) * 256 + HALF + n * 16 + colw); } }
                    if (m == 3 && fr == 15) { dg = z4; dv = z4; if (rb < 3) { dg = *(const PG8_LAS f32x4*)(xl + ((rb + 1) * 2) * 256 + n * 16 + colw); dv = *(const PG8_LAS f32x4*)(xl + ((rb + 1) * 2) * 256 + HALF + n * 16 + colw); } }
                    const f32x4 gg = k0g * ug + k1g * cg_ + k2g * dg + bg, vv = k0v * uv + k1v * cv_ + k2v * dv + bv;
                    const size_t row = (size_t)u.pm * BM + ai * HALF + wr * 64 + m * 16 + fr;
                    *(u32x2*)(act + row * DFF + gc) = pack4(silu_mul(gg, vv));
                }
            }
        }
    }
};
}
#define LAS __attribute__((address_space(3)))
typedef unsigned short bf16;
typedef float f32x4 __attribute__((ext_vector_type(4)));
typedef float f32x16 __attribute__((ext_vector_type(16)));
typedef short bf16x8 __attribute__((ext_vector_type(8)));
typedef short s16x4 __attribute__((ext_vector_type(4)));
typedef unsigned u32x4 __attribute__((ext_vector_type(4)));
typedef unsigned u32x2 __attribute__((ext_vector_type(2)));
using pg8::cvtpk; using pg8::pack4;
__device__ __forceinline__ float wave_sum(float v) {
#pragma unroll
    for (int o = 1; o < 64; o <<= 1) v += __shfl_xor(v, o);
    return v;
}
__device__ __forceinline__ float bf_lo(unsigned w) { return __builtin_bit_cast(float, w << 16); }
__device__ __forceinline__ float bf_hi(unsigned w) { return __builtin_bit_cast(float, w & 0xffff0000u); }
__device__ __forceinline__ float half_max(float v) { return fmaxf(v, __shfl_xor(v, 32)); }
__device__ __forceinline__ float half_sum(float v) { return v + __shfl_xor(v, 32); }

constexpr size_t MiB = 1u << 20;
constexpr size_t WS_CTL = 0, CTL_ZERO_BYTES = 32768;
constexpr size_t WS_MOD = 1 * MiB, WS_ROPE = 2 * MiB;
constexpr size_t WS_WIN = 4 * MiB, WS_WOUT = 20 * MiB, WS_WUP = 28 * MiB, WS_WDOWN = 71 * MiB, WS_WPOOL = 93 * MiB;
constexpr size_t WS_H = 94 * MiB, WS_Q = 174 * MiB, WS_KC = 214 * MiB, WS_KL = 222 * MiB, WS_VTC = 262 * MiB, WS_VTL = 270 * MiB, WS_P = 310 * MiB, WS_POOLED = 350 * MiB;
constexpr size_t WS_AM = 390 * MiB, WS_EBUF = 470 * MiB, WS_ACT = 174 * MiB, WS_END = 484 * MiB;
static_assert(WS_ACT + (size_t)MROWS * DFF * 2 <= WS_AM, "act overlay");
static_assert(WS_EBUF + (size_t)80 * 4 * NUP * 4 <= WS_END, "ebuf");
constexpr int RING_BYTES = 131072, XL_OFF = RING_BYTES, LDS_BYTES = 147456;

__device__ __forceinline__ void transpose_item(const float* W, int ldw, int k0, int n0, bf16* WT, int ldt, int drow0, LAS float* scr, int lane) {
#pragma unroll 8
    for (int i = 0; i < 32; ++i) { const int kk = 2 * i + (lane >> 5); scr[kk * 33 + (lane & 31)] = W[(size_t)(k0 + kk) * ldw + n0 + (lane & 31)]; }
    asm volatile("s_waitcnt lgkmcnt(0)" ::: "memory");
    const int c = lane & 7;
#pragma unroll
    for (int j = 0; j < 4; ++j) { const int n = (lane >> 3) + 8 * j; const LAS float* s = scr + (8 * c) * 33 + n;
        u32x4 o; o.x = cvtpk(s[0 * 33], s[1 * 33]); o.y = cvtpk(s[2 * 33], s[3 * 33]); o.z = cvtpk(s[4 * 33], s[5 * 33]); o.w = cvtpk(s[6 * 33], s[7 * 33]);
        *(u32x4*)(WT + (size_t)(drow0 + n) * ldt + k0 + 8 * c) = o; }
    asm volatile("s_waitcnt lgkmcnt(0)" ::: "memory");
}
constexpr int IT_WIN = (DM / 64) * (DIN / 32), IT_WOUT = (DM / 64) * (DM / 32), IT_WUP = (DM / 64) * (NUP / 32), IT_WDOWN = (DFF / 64) * (DM / 32), IT_WPOOL = 4 * 4 * 8,
              IT_CV = 8 * (PAST / 64) * (DATT / 32), IT_CK = 8 * PAST;
constexpr int IT_TOTAL = IT_WIN + IT_WOUT + IT_WUP + IT_WDOWN + IT_WPOOL + IT_CV + IT_CK;

struct Args { const float* in[24]; float* outp; unsigned char* wsp; };

__device__ __forceinline__ void norm_row(const float* xrow, const float* g, const float* sc, const float* sh, bf16* outb, float* outf, int lane, const bf16* addb = nullptr, const bf16* addc = nullptr) {
    const f32x4* xr = (const f32x4*)xrow + lane;
    f32x4 v[8]; float s = 0.f;
#pragma unroll
    for (int j = 0; j < 8; ++j) { v[j] = xr[64 * j];
        if (addb) { const u32x2 d_ = ((const u32x2*)addb + lane)[64 * j]; v[j] += (f32x4){bf_lo(d_.x), bf_hi(d_.x), bf_lo(d_.y), bf_hi(d_.y)}; }
        if (addc) { const u32x2 d_ = ((const u32x2*)addc + lane)[64 * j]; v[j] += (f32x4){bf_lo(d_.x), bf_hi(d_.x), bf_lo(d_.y), bf_hi(d_.y)}; }
        s += (v[j].x * v[j].x + v[j].y * v[j].y) + (v[j].z * v[j].z + v[j].w * v[j].w); }
    const float rstd = 1.0f / sqrtf(wave_sum(s) * (1.0f / DM) + EPS);
#pragma unroll
    for (int j = 0; j < 8; ++j) {
        const int c = 4 * lane + 256 * j;
        f32x4 y = v[j] * rstd * *(const f32x4*)(g + c);
        if (sc) y = y * (1.0f + *(const f32x4*)(sc + c)) + *(const f32x4*)(sh + c);
        if (outb) *(u32x2*)(outb + c) = pack4(y); else *(f32x4*)(outf + c) = y;
    }
}

template <int HW> __device__ __forceinline__ void pool_item(const bf16* base, bf16* obase, int t0, int T) {
    constexpr int NR = 7 + 2 * HW;
    u32x4 rows[NR];
#pragma unroll
    for (int j = 0; j < NR; ++j) { const int tt = t0 - HW + j; rows[j] = (tt >= 0 && tt < T) ? *(const u32x4*)(base + (size_t)tt * DATT) : (u32x4){0u, 0u, 0u, 0u}; }
    float s[8];
#pragma unroll
    for (int i = 0; i < 8; ++i) s[i] = 0.f;
#define POOL_ADD(SGN, v_) { s[0] SGN bf_lo(v_.x); s[1] SGN bf_hi(v_.x); s[2] SGN bf_lo(v_.y); s[3] SGN bf_hi(v_.y); s[4] SGN bf_lo(v_.z); s[5] SGN bf_hi(v_.z); s[6] SGN bf_lo(v_.w); s[7] SGN bf_hi(v_.w); }
#pragma unroll
    for (int j = 0; j < 2 * HW; ++j) POOL_ADD(+=, rows[j])
#pragma unroll
    for (int i = 0; i < 8; ++i) {
        const int t = t0 + i, lo = max(t - HW, 0), hi = min(t + HW, T); const float ic = 1.0f / (float)(hi - lo); const u32x4 ov = rows[i + HW];
        u32x4 w; w.x = cvtpk(s[0] * ic - bf_lo(ov.x), s[1] * ic - bf_hi(ov.x)); w.y = cvtpk(s[2] * ic - bf_lo(ov.y), s[3] * ic - bf_hi(ov.y));
        w.z = cvtpk(s[4] * ic - bf_lo(ov.z), s[5] * ic - bf_hi(ov.z)); w.w = cvtpk(s[6] * ic - bf_lo(ov.w), s[7] * ic - bf_hi(ov.w));
        *(u32x4*)(obase + (size_t)t * DATT) = w;
        if (i < 7) { POOL_ADD(+=, rows[i + 2 * HW]) POOL_ADD(-=, rows[i]) }
    }
#undef POOL_ADD
}

namespace att {
constexpr int KSTRB = 272, VSTRB = 144, KBYTES = 64 * KSTRB, VBYTES = 128 * VSTRB, V_OFF = 2 * KBYTES, OX_OFF = 0;
static_assert(V_OFF + 3 * VBYTES <= 131072 && 65536 <= 131072, "attention LDS");
__device__ __forceinline__ int crow(int r, int hi) { return (r & 3) + 8 * (r >> 2) + 4 * hi; }
__device__ __forceinline__ void pv_tile(f32x16 (&o)[4], LAS unsigned char* vbase, const bf16x8 (&pb)[4]) {
#pragma unroll
    for (int ks = 0; ks < 4; ++ks) {
        bf16x8 vf[4];
#pragma unroll
        for (int d = 0; d < 4; ++d) vf[d] = *(const LAS bf16x8*)(vbase + d * 32 * VSTRB + ks * 32);
#pragma unroll
        for (int d = 0; d < 4; ++d) o[d] = __builtin_amdgcn_mfma_f32_32x32x16_bf16(vf[d], pb[ks], o[d], 0, 0, 0);
    }
}
__device__ __forceinline__ void unit(LAS unsigned char* lds, const bf16* Qp, const bf16* Kg, const bf16* Vtg, int tall, int nt, bf16* Op, float lam, const float* subg) {
    const int tid = threadIdx.x, lane = tid & 63, r = lane & 31, hi = lane >> 5, wid = __builtin_amdgcn_readfirstlane(tid >> 6), rg = wid & 3, mp = wid >> 2;
    bf16x8 qf[4];
    { const bf16* qp = Qp + (size_t)(rg * 32 + r) * DATT + mp * 64 + hi * 8;
#pragma unroll
      for (int s = 0; s < 4; ++s) qf[s] = *(const bf16x8*)(qp + 16 * s); }
    f32x16 o[4];
#pragma unroll
    for (int d = 0; d < 4; ++d)
#pragma unroll
        for (int i = 0; i < 16; ++i) o[d][i] = 0.f;
    float m_run = 0.f, l_run = 0.f;
    const bf16* ksrc[2]; const bf16* vsrc[2]; int kdst[2], vdst[2];
#pragma unroll
    for (int i = 0; i < 2; ++i) { const int id = tid + 512 * i; ksrc[i] = Kg + (size_t)(id >> 4) * DATT + (id & 15) * 8; kdst[i] = (id >> 4) * KSTRB + (id & 15) * 16;
        vsrc[i] = Vtg + (size_t)(id >> 3) * tall + (id & 7) * 8; vdst[i] = V_OFF + (id >> 3) * VSTRB + ((id & 7) >> 1) * 32 + (id & 1) * 8; }
    u32x4 kr[2], vr[2];
#pragma unroll
    for (int i = 0; i < 2; ++i) { kr[i] = *(const u32x4*)ksrc[i]; vr[i] = *(const u32x4*)vsrc[i]; }
#pragma unroll
    for (int i = 0; i < 2; ++i) { *(LAS u32x4*)(lds + kdst[i]) = kr[i]; *(LAS u32x2*)(lds + vdst[i]) = (u32x2){vr[i].x, vr[i].y}; *(LAS u32x2*)(lds + vdst[i] + 16) = (u32x2){vr[i].z, vr[i].w}; }
    __syncthreads();
    const int koff = r * KSTRB + (mp * 64 + hi * 8) * 2, voff = V_OFF + r * VSTRB + hi * 16;
    bf16x8 pb[4];
#pragma unroll
    for (int i = 0; i < 4; ++i) pb[i] = (bf16x8){0, 0, 0, 0, 0, 0, 0, 0};
    int vcur = 0, vprev = 0;
    for (int t = 0; t < nt; ++t) {
        const int kcur = (t & 1) * KBYTES, knxt = KBYTES - kcur, vnxt = (vcur == 2 * VBYTES) ? 0 : vcur + VBYTES;
        if (t + 1 < nt) {
#pragma unroll
            for (int i = 0; i < 2; ++i) { kr[i] = *(const u32x4*)(ksrc[i] + (size_t)(t + 1) * 64 * DATT); vr[i] = *(const u32x4*)(vsrc[i] + (t + 1) * 64); }
        }
        f32x16 p0, p1;
#define ATT_QK(C0) { _Pragma("unroll") for (int i = 0; i < 16; ++i) { p0[i] = 0.f; p1[i] = 0.f; } _Pragma("unroll") for (int s = 0; s < 4; ++s) { \
            const bf16x8 a0 = *(const LAS bf16x8*)(lds + kcur + koff + s * 32), a1 = *(const LAS bf16x8*)(lds + kcur + koff + 32 * KSTRB + s * 32); \
            p0 = __builtin_amdgcn_mfma_f32_32x32x16_bf16(a0, qf[s], p0, 0, 0, 0); p1 = __builtin_amdgcn_mfma_f32_32x32x16_bf16(a1, qf[s], p1, 0, 0, 0); } }
#define ATT_ROWMAX(mx) { mx = fmaxf(p0[0], p1[0]); _Pragma("unroll") for (int i = 1; i < 16; ++i) mx = fmaxf(mx, fmaxf(p0[i], p1[i])); mx = half_max(mx); }
        float rs;
        for (bool redo = false;;) {
            ATT_QK(0)
            if (t == 0 || redo) {
                float mx; ATT_ROWMAX(mx)
                if (t != 0) { mx = fmaxf(mx - m_run, 0.f); const float alpha = __builtin_amdgcn_exp2f(-mx); l_run *= alpha;
#pragma unroll
                    for (int d = 0; d < 4; ++d)
#pragma unroll
                        for (int i = 0; i < 16; ++i) o[d][i] *= alpha; }
                m_run += mx;
            }
            rs = 0.f;
#pragma unroll
            for (int i = 0; i < 16; ++i) { p0[i] = __builtin_amdgcn_exp2f(p0[i] - m_run); p1[i] = __builtin_amdgcn_exp2f(p1[i] - m_run); rs += p0[i] + p1[i]; }
            if (redo || !__any(!(rs < 1e18f))) break;
            redo = true;
        }
        l_run += rs;
#undef ATT_QK
#undef ATT_ROWMAX
#pragma unroll
        for (int s = 0; s < 2; ++s) {
            u32x4 w0, w1;
            w0.x = cvtpk(p0[8 * s + 0], p0[8 * s + 1]); w0.y = cvtpk(p0[8 * s + 2], p0[8 * s + 3]); w0.z = cvtpk(p0[8 * s + 4], p0[8 * s + 5]); w0.w = cvtpk(p0[8 * s + 6], p0[8 * s + 7]);
            w1.x = cvtpk(p1[8 * s + 0], p1[8 * s + 1]); w1.y = cvtpk(p1[8 * s + 2], p1[8 * s + 3]); w1.z = cvtpk(p1[8 * s + 4], p1[8 * s + 5]); w1.w = cvtpk(p1[8 * s + 6], p1[8 * s + 7]);
            pb[s] = __builtin_bit_cast(bf16x8, w0); pb[2 + s] = __builtin_bit_cast(bf16x8, w1);
        }
        pv_tile(o, lds + vcur + voff, pb);
        __builtin_amdgcn_iglp_opt(0);
        if (t + 1 < nt) {
#pragma unroll
            for (int i = 0; i < 2; ++i) { *(LAS u32x4*)(lds + knxt + kdst[i]) = kr[i]; *(LAS u32x2*)(lds + vnxt + vdst[i]) = (u32x2){vr[i].x, vr[i].y}; *(LAS u32x2*)(lds + vnxt + vdst[i] + 16) = (u32x2){vr[i].z, vr[i].w}; }
        }
        vprev = vcur; vcur = vnxt;
        __syncthreads();
    }
    __syncthreads();
    const float inv = 1.0f / half_sum(l_run);
    LAS float* ox = (LAS float*)(lds + OX_OFF) + rg * 4096 + lane;
    if (mp == 1) {
        const float f = inv * lam;
#pragma unroll
        for (int d = 0; d < 4; ++d)
#pragma unroll
            for (int i = 0; i < 16; ++i) ox[(d * 16 + i) * 64] = o[d][i] * f;
    }
    __syncthreads();
    if (mp == 0) {
        float ss = 0.f;
#pragma unroll
        for (int d = 0; d < 4; ++d)
#pragma unroll
            for (int i = 0; i < 16; ++i) { const float a = o[d][i] * inv - ox[(d * 16 + i) * 64]; o[d][i] = a; ss += a * a; }
        ss = half_sum(ss);
        const float rn = (1.0f / sqrtf(ss * (1.0f / 128.0f) + EPS)) * 0.8f;
        bf16* orow = Op + (size_t)(rg * 32 + r) * DM;
#pragma unroll
        for (int d = 0; d < 4; ++d)
#pragma unroll
            for (int g = 0; g < 4; ++g) { const int d0 = 32 * d + 8 * g + 4 * hi; const f32x4 gv = *(const f32x4*)(subg + d0);
                const f32x4 y = {o[d][4 * g] * rn * gv[0], o[d][4 * g + 1] * rn * gv[1], o[d][4 * g + 2] * rn * gv[2], o[d][4 * g + 3] * rn * gv[3]};
                *(u32x2*)(orow + d0) = pack4(y); }
    }
    __syncthreads();
}
}

constexpr int ARGS_OFF = 147200;
__device__ __forceinline__ void* ldarg(LAS unsigned char* lds, int i) {
    const unsigned long long v = ((const LAS unsigned long long*)(lds + ARGS_OFF))[i];
    const unsigned lo = __builtin_amdgcn_readfirstlane((unsigned)v), hi = __builtin_amdgcn_readfirstlane((unsigned)(v >> 32));
    return (void*)(__attribute__((address_space(1))) void*)(((unsigned long long)hi << 32) | lo);
}
#define LDARG(i) ldarg(lds, (i))
#define x_prompt ((const float*)LDARG(0))
#define x_sample ((const float*)LDARG(1))
#define cin ((const float*)LDARG(2))
#define cache_k ((const float*)LDARG(3))
#define cache_v ((const float*)LDARG(4))
#define c_ctx ((const float*)LDARG(5))
#define w_ada ((const float*)LDARG(6))
#define b_ada ((const float*)LDARG(7))
#define norm1_g ((const float*)LDARG(8))
#define w_in ((const float*)LDARG(9))
#define lam_q1 ((const float*)LDARG(10))
#define lam_k1 ((const float*)LDARG(11))
#define lam_q2 ((const float*)LDARG(12))
#define lam_k2 ((const float*)LDARG(13))
#define subln_g ((const float*)LDARG(14))
#define w_pool ((const float*)LDARG(15))
#define pool_scale ((const float*)LDARG(16))
#define w_out ((const float*)LDARG(17))
#define norm2_g ((const float*)LDARG(18))
#define w_up ((const float*)LDARG(19))
#define conv_k ((const float*)LDARG(20))
#define conv_b ((const float*)LDARG(21))
#define w_down ((const float*)LDARG(22))
#define norm_f_g ((const float*)LDARG(23))
#define out ((float*)LDARG(24))
#define ws ((unsigned char*)LDARG(25))
#define state_k (out + (size_t)MROWS * DM)
#define state_v (out + (size_t)MROWS * DM + (size_t)NCTX * DATT)
#define ctl ((unsigned*)(ws + WS_CTL))
#define mod ((float*)(ws + WS_MOD))
#define rope ((float*)(ws + WS_ROPE))
#define WinT ((bf16*)(ws + WS_WIN))
#define WoutT ((bf16*)(ws + WS_WOUT))
#define WupT ((bf16*)(ws + WS_WUP))
#define WdownT ((bf16*)(ws + WS_WDOWN))
#define WpoolT ((bf16*)(ws + WS_WPOOL))
#define Hb ((bf16*)(ws + WS_H))
#define Qb ((bf16*)(ws + WS_Q))
#define Kc ((bf16*)(ws + WS_KC))
#define Kl ((bf16*)(ws + WS_KL))
#define Vtc ((bf16*)(ws + WS_VTC))
#define Vtl ((bf16*)(ws + WS_VTL))
#define Pb ((bf16*)(ws + WS_P))
#define Pooled ((bf16*)(ws + WS_POOLED))
#define AM ((bf16*)(ws + WS_AM))
#define ACT ((bf16*)(ws + WS_ACT))
#define ebuf ((float*)(ws + WS_EBUF))
#define RLX_AGENT __ATOMIC_RELAXED, __HIP_MEMORY_SCOPE_AGENT
#define XB_TMO      128
#define XB_XCNT(j)  (256  + 64 * (j))
#define XB_XSUB(j)  (1280 + 64 * (j))
#define XB_XGEN(j)  (2304 + 64 * (j))
#define XB_TOP      3328
#define XB_TOPGEN   3392
#define XCD_BAR_WORDS 3456
#define XB_SPIN_CAP (1u << 18)

__device__ __forceinline__ unsigned xb_ld(unsigned* p)              { return __hip_atomic_load(p, __ATOMIC_RELAXED, __HIP_MEMORY_SCOPE_AGENT); }
__device__ __forceinline__ unsigned xb_add(unsigned* p, unsigned v) { return __hip_atomic_fetch_add(p, v, __ATOMIC_RELAXED, __HIP_MEMORY_SCOPE_AGENT); }
__device__ __forceinline__ unsigned xb_xcc_id() { return (unsigned)__builtin_amdgcn_s_getreg((3 << 11) | 20) & 0xFu; }
#define XB_SPIN(cond, bar) do { unsigned _sp = 0; while (cond) { __builtin_amdgcn_s_sleep(1); \
    if ((++_sp & 255u) == 0u) { if (xb_ld(&(bar)[XB_TMO])) break; if (_sp > XB_SPIN_CAP) { atomicAdd(&(bar)[XB_TMO], 1u); break; } } } } while (0)

struct XcdBarrier {
    unsigned* bar; unsigned x;
    volatile LAS unsigned* st;
};

__device__ __forceinline__ XcdBarrier xcd_barrier_post(unsigned* bar, volatile LAS unsigned* st) {
    XcdBarrier b; b.bar = bar; b.x = xb_xcc_id(); b.st = st;
    if (threadIdx.x == 0) (void)xb_add(&bar[XB_XCNT(b.x)], 1u);
    return b;
}
__device__ __forceinline__ void xcd_barrier_complete(unsigned* bar, unsigned x, unsigned& nloc, unsigned& nx) {
    const unsigned G = gridDim.x * gridDim.y * gridDim.z;
    unsigned sum, cnt, mine, sp = 0u;
    for (;;) {
        sum = 0u; cnt = 0u; mine = 0u;
#pragma unroll
        for (unsigned j = 0; j < 16; ++j) { const unsigned c = xb_ld(&bar[XB_XCNT(j)]); sum += c; cnt += (c > 0u) ? 1u : 0u; mine = (j == x) ? c : mine; }
        if (sum == G) break;
        __builtin_amdgcn_s_sleep(1);
        if ((++sp & 255u) == 0u) { if (xb_ld(&bar[XB_TMO])) break; if (sp > XB_SPIN_CAP) { atomicAdd(&bar[XB_TMO], 1u); break; } }
    }
    nloc = mine > 0u ? mine : 1u; nx = cnt > 0u ? cnt : 1u;
}

__device__ __forceinline__ void xcd_barrier(const XcdBarrier& b) {
    asm volatile("s_waitcnt vmcnt(0)" ::: "memory");
    __syncthreads();
    if (threadIdx.x == 0) {
        unsigned* bar = b.bar;
        __builtin_amdgcn_s_waitcnt(0);
        unsigned nloc = b.st[0], nx = b.st[1];
        if (nloc == 0u) { xcd_barrier_complete(bar, b.x, nloc, nx); b.st[0] = nloc; b.st[1] = nx; }
        const unsigned old = xb_add(&bar[XB_XSUB(b.x)], 1u);
        const unsigned gen = old / nloc;
        if (old + 1u == (gen + 1u) * nloc) {
            __builtin_amdgcn_fence(__ATOMIC_RELEASE, "agent");
            asm volatile("s_waitcnt vmcnt(0)" ::: "memory");
            const unsigned og = xb_add(&bar[XB_TOP], 1u);
            const unsigned tg = og / nx;
            if (og + 1u == (tg + 1u) * nx) xb_add(&bar[XB_TOPGEN], 1u);
            else XB_SPIN(xb_ld(&bar[XB_TOPGEN]) == tg, bar);
            __builtin_amdgcn_fence(__ATOMIC_ACQUIRE, "agent");
            xb_add(&bar[XB_XGEN(b.x)], 1u);
            asm volatile("s_waitcnt vmcnt(0)" ::: "memory");
        } else {
            XB_SPIN(xb_ld(&bar[XB_XGEN(b.x)]) == gen, bar);
            __builtin_amdgcn_fence(__ATOMIC_ACQUIRE, "agent");
            asm volatile("s_waitcnt vmcnt(0)" ::: "memory");
        }
    }
    __syncthreads();
}

constexpr int CW_BAR = 1024, MISC_OFF = 147416;
struct MidBar { LAS unsigned char* lds; int at;
    __device__ __forceinline__ void operator()(int ui) const { if (ui == at) { XcdBarrier b_; b_.bar = (unsigned*)((unsigned char*)ldarg(lds, 25) + WS_CTL) + CW_BAR; b_.x = xb_xcc_id(); b_.st = (volatile LAS unsigned*)(lds + MISC_OFF); xcd_barrier(b_); } } };
__global__ void __launch_bounds__(512, 2) fwd_kernel(Args args) {
    extern __shared__ __attribute__((aligned(16))) unsigned char lds_raw[];
    LAS unsigned char* lds = (LAS unsigned char*)lds_raw;
    cg::grid_group grid = cg::this_grid();
    const int tid = threadIdx.x, lane = tid & 63, wave = __builtin_amdgcn_readfirstlane(tid >> 6);
    const int G = gridDim.x, bx = blockIdx.x;
    const int vcu = (G % 8 == 0) ? (bx % 8) * (G / 8) + bx / 8 : bx;
    const int gw = vcu * 8 + wave, NGW = G * 8;
    const int gt = bx * 512 + tid, GT = G * 512;
    if (tid == 0) { LAS unsigned long long* ap = (LAS unsigned long long*)(lds + ARGS_OFF);
        ap[0] = (unsigned long long)args.in[0];
        ap[1] = (unsigned long long)args.in[1];
        ap[2] = (unsigned long long)args.in[2];
        ap[3] = (unsigned long long)args.in[3];
        ap[4] = (unsigned long long)args.in[4];
        ap[5] = (unsigned long long)args.in[5];
        ap[6] = (unsigned long long)args.in[6];
        ap[7] = (unsigned long long)args.in[7];
        ap[8] = (unsigned long long)args.in[8];
        ap[9] = (unsigned long long)args.in[9];
        ap[10] = (unsigned long long)args.in[10];
        ap[11] = (unsigned long long)args.in[11];
        ap[12] = (unsigned long long)args.in[12];
        ap[13] = (unsigned long long)args.in[13];
        ap[14] = (unsigned long long)args.in[14];
        ap[15] = (unsigned long long)args.in[15];
        ap[16] = (unsigned long long)args.in[16];
        ap[17] = (unsigned long long)args.in[17];
        ap[18] = (unsigned long long)args.in[18];
        ap[19] = (unsigned long long)args.in[19];
        ap[20] = (unsigned long long)args.in[20];
        ap[21] = (unsigned long long)args.in[21];
        ap[22] = (unsigned long long)args.in[22];
        ap[23] = (unsigned long long)args.in[23];
        ap[24] = (unsigned long long)args.outp; ap[25] = (unsigned long long)args.wsp;
        ((LAS unsigned*)(lds + MISC_OFF))[0] = 0u; ((LAS unsigned*)(lds + MISC_OFF))[1] = 0u; }
    __syncthreads();
    { XcdBarrier b0_ = xcd_barrier_post(ctl + CW_BAR, (volatile LAS unsigned*)(lds + MISC_OFF)); (void)b0_; }
#define GRID_BAR() do { XcdBarrier b_; b_.bar = ctl + CW_BAR; b_.x = xb_xcc_id(); b_.st = (volatile LAS unsigned*)(lds + MISC_OFF); xcd_barrier(b_); } while (0)

#if PH0
    if (bx == G - 1) {
        for (int e = tid; e < 1024; e += 512) { const int pos = e >> 4, f = e & 15; const float inv = exp2f(-(float)f * (13.287712379549449f / 16.0f)); const float a = (float)pos * inv; float sn, cs; sincosf(a, &sn, &cs); rope[2 * e] = cs; rope[2 * e + 1] = sn; }
    }
    for (int j = bx; j < 128; j += G) {
        LAS float* scond = (LAS float*)lds; LAS float* red = (LAS float*)(lds + 73728);
        for (int e = tid; e < 9 * DM; e += 512) { const int b = e >> 11, k = e & 2047; const float v = (b < 8) ? cin[b * DM + k] : c_ctx[k]; scond[e] = v / (1.0f + expf(-v)); }
        __syncthreads();
        const int cgp = tid % 24, kl = tid / 24;
        f32x4 acc[9];
#pragma unroll
        for (int b = 0; b < 9; ++b) acc[b] = (f32x4){0.f, 0.f, 0.f, 0.f};
        if (kl < 21) {
            const float* wp = w_ada + 96 * j + 4 * cgp;
#pragma unroll 4
            for (int k = kl; k < DM; k += 21) { const f32x4 w = *(const f32x4*)(wp + (size_t)k * NMOD);
#pragma unroll
                for (int b = 0; b < 9; ++b) acc[b] += w * scond[b * DM + k]; }
#pragma unroll
            for (int b = 0; b < 9; ++b) *(LAS f32x4*)(red + (kl * 9 + b) * 96 + 4 * cgp) = acc[b];
        }
        __syncthreads();
        for (int e = tid; e < 9 * 96; e += 512) { const int b = e / 96, c = e % 96; float s = b_ada[96 * j + c];
            for (int q = 0; q < 21; ++q) s += red[(q * 9 + b) * 96 + c];
            mod[b * NMOD + 96 * j + c] = s; }
        __syncthreads();
    }
    {
        LAS float* scr = (LAS float*)(lds + wave * 8448);
        for (;;) {
            int it = 0; if (lane == 0) it = (int)atomicAdd(ctl, 1u); it = __builtin_amdgcn_readfirstlane(it);
            if (it >= IT_TOTAL) break;
            int r_ = it;
            if (r_ < IT_WIN) { const int nb = DIN / 32; transpose_item(w_in, DIN, 64 * (r_ / nb), 32 * (r_ % nb), WinT, DM, 32 * (r_ % nb), scr, lane); continue; } r_ -= IT_WIN;
            if (r_ < IT_WOUT) { const int nb = DM / 32; transpose_item(w_out, DM, 64 * (r_ / nb), 32 * (r_ % nb), WoutT, DM, 32 * (r_ % nb), scr, lane); continue; } r_ -= IT_WOUT;
            if (r_ < IT_WUP) { const int nb = NUP / 32; const int n0 = 32 * (r_ % nb); const int drow = n0 < DFF ? (n0 / 128) * 256 + (n0 % 128) : ((n0 - DFF) / 128) * 256 + 128 + ((n0 - DFF) % 128);
                transpose_item(w_up, NUP, 64 * (r_ / nb), n0, WupT, DM, drow, scr, lane); continue; } r_ -= IT_WUP;
            if (r_ < IT_WDOWN) { const int nb = DM / 32; transpose_item(w_down, DM, 64 * (r_ / nb), 32 * (r_ % nb), WdownT, DFF, 32 * (r_ % nb), scr, lane); continue; } r_ -= IT_WDOWN;
            if (r_ < IT_WPOOL) { const int g = r_ >> 5, q = r_ & 31; transpose_item(w_pool + (size_t)g * 65536, 256, 64 * (q >> 3), 32 * (q & 7), WpoolT + (size_t)g * 65536, 256, 32 * (q & 7), scr, lane); continue; } r_ -= IT_WPOOL;
            if (r_ < IT_CV) { const int b = r_ >> 8, q = r_ & 255;
                transpose_item(cache_v + (size_t)b * PAST * DATT, DATT, 64 * (q >> 5), 32 * (q & 31), Vtl + (size_t)b * DATT * TALL, TALL, 32 * (q & 31), scr, lane); continue; } r_ -= IT_CV;
            { const int b = r_ >> 9, key = r_ & 511; const f32x4* src = (const f32x4*)(cache_k + ((size_t)b * PAST + key) * DATT); bf16* dst = Kl + ((size_t)b * TALL + key) * DATT;
#pragma unroll
              for (int j = 0; j < 4; ++j) *(u32x2*)(dst + 4 * lane + 256 * j) = pack4(src[lane + 64 * j]); }
        }
    }
#endif
    grid.sync();
#if PH1
    for (int row = gw; row < MROWS; row += NGW) {
        const float* xr = row < NCTX ? x_prompt + (size_t)row * DM : x_sample + (size_t)(row - NCTX) * DM; const int bidx = row < NCTX ? 8 : (row - NCTX) >> 11;
        norm_row(xr, norm1_g, mod + (size_t)bidx * NMOD + DM, mod + (size_t)bidx * NMOD, Hb + (size_t)row * DM, nullptr, lane);
    }
#endif
    GRID_BAR();
#if PH2
    {
        pg8::Gemm g{Hb, WinT, DM, DM, DM, 0}; pg8::StaticOrder S; S.init(MROWS, DIN, G, bx);
        pg8::EpiInProj E{Qb, Kc, Kl, Vtc, Vtl, Pb, state_k, state_v, rope};
        pg8::gemm_phase<pg8::EpiInProj, pg8::StaticOrder, true, true>(lds, g, S, E);
    }
#endif
    GRID_BAR();
#if PH3
    for (int item = gt; item < (MROWS / 8) * 128; item += GT) {
        const int g = (item >> 6) & 3, rb8 = (item >> 8) * 2 + ((item >> 5) & 1), c8 = g * 32 + (item & 31);
        const int row0 = rb8 * 8;
        const int T = row0 < NCTX ? TCTX : TLAT, t0 = row0 < NCTX ? (row0 & (TCTX - 1)) : ((row0 - NCTX) & (TLAT - 1));
        const bf16* base = Pb + (size_t)(row0 - t0) * DATT + c8 * 8; bf16* obase = Pooled + (size_t)(row0 - t0) * DATT + c8 * 8;
        if (g == 0) pool_item<1>(base, obase, t0, T); else if (g == 1) pool_item<2>(base, obase, t0, T); else if (g == 2) pool_item<4>(base, obase, t0, T); else pool_item<8>(base, obase, t0, T);
    }
    {
        const float s1 = wave_sum(lam_q1[lane] * lam_k1[lane]), s2 = wave_sum(lam_q2[lane] * lam_k2[lane]);
        const float lam = expf(s1) - expf(s2) + 0.2f;
        const int per = (1024 + G - 1) / G;
        for (int i = 0; i < per; ++i) { const int idx = vcu * per + i; if (idx >= 1024) break;
            const int b = idx >> 7, h = (idx >> 4) & 7, qb = idx & 15; const size_t qrow0 = (size_t)NCTX + (size_t)b * TLAT + qb * 128;
            att::unit(lds, Qb + qrow0 * DATT + h * 128, Kl + (size_t)b * TALL * DATT + h * 128, Vtl + (size_t)(b * 8 + h) * 128 * TALL, TALL, TALL / 64, AM + qrow0 * DM + h * 128, lam, subln_g); }
        for (int idx = vcu; idx < 256; idx += G) {
            const int b = idx >> 4, h = (idx >> 1) & 7, qb = idx & 1; const size_t qrow0 = (size_t)b * TCTX + qb * 128;
            att::unit(lds, Qb + qrow0 * DATT + h * 128, Kc + (size_t)b * TCTX * DATT + h * 128, Vtc + (size_t)(b * 8 + h) * 128 * TCTX, TCTX, TCTX / 64, AM + qrow0 * DM + h * 128, lam, subln_g); }
    }
#endif
    GRID_BAR();
#if PH3B
    {
        int kp = 256; asm volatile("" : "+s"(kp));
        pg8::Gemm g{Pooled, WpoolT, DATT, 256, kp, 256}; pg8::StaticOrder S; S.init(MROWS, DATT, G, bx);
        pg8::EpiPool E{AM, pool_scale};
        pg8::gemm_phase<pg8::EpiPool, pg8::StaticOrder, true, true>(lds, g, S, E);
    }
#endif
    GRID_BAR();
#if PH4
    {
        pg8::Gemm g{AM, WoutT, DM, DM, DM, 0}; pg8::PanelOrder S; S.init(MROWS, DM, G, bx);
        pg8::EpiGateBf16 E{Hb, mod + 2 * DM};
        MidBar MB{lds, S.fast ? 1 : -1};
        pg8::gemm_phase<pg8::EpiGateBf16, pg8::PanelOrder, true, true, MidBar>(lds, g, S, E, MB);
#define P5_ROW(row) { const int bidx = (row) < NCTX ? 8 : ((row) - NCTX) >> 11; const float* xr = (row) < NCTX ? x_prompt + (size_t)(row) * DM : x_sample + (size_t)((row) - NCTX) * DM; \
        norm_row(xr, norm2_g, mod + (size_t)bidx * NMOD + 4 * DM, mod + (size_t)bidx * NMOD + 3 * DM, AM + (size_t)(row) * DM, nullptr, lane, Hb + (size_t)(row) * DM, nullptr); }
        if (S.fast && bx >= 128) {
            for (int row = (bx - 128) * 8 + wave; row < 44 * 256; row += 1024) P5_ROW(row)
        }
    }
#endif
    GRID_BAR();
#if PH5
    for (int row = (G == 256 ? 44 * 256 : 0) + gw; row < MROWS; row += NGW) P5_ROW(row)
#undef P5_ROW
#endif
    GRID_BAR();
#if PH6
    {
        pg8::Gemm g{AM, WupT, DM, DM, DM, 0}; pg8::StaticOrder S; S.init(MROWS, NUP, G, bx);
        pg8::EpiUp E{ACT, ebuf, conv_k, conv_b, (LAS float*)(lds + XL_OFF)};
        pg8::gemm_phase<pg8::EpiUp, pg8::StaticOrder, true, true>(lds, g, S, E);
    }
#endif
    GRID_BAR();
#if PH7
    for (int item = gt; item < 56 * DFF; item += GT) {
        const int bnd = item / DFF, j = item % DFF; const int pmA = 16 + (bnd / 7) * 8 + (bnd % 7), pmB = pmA + 1;
        const int tcg = (j >> 7) * 256 + (j & 127), tcv = tcg + 128;
        const float* eA = ebuf + (size_t)pmA * 4 * NUP; const float* eB = ebuf + (size_t)pmB * 4 * NUP;
        const float g254 = eA[2 * NUP + tcg], g255 = eA[3 * NUP + tcg], g0 = eB[tcg], g1 = eB[NUP + tcg];
        const float v254 = eA[2 * NUP + tcv], v255 = eA[3 * NUP + tcv], v0 = eB[tcv], v1 = eB[NUP + tcv];
        const float k0g = conv_k[j], k1g = conv_k[NUP + j], k2g = conv_k[2 * NUP + j], bg = conv_b[j];
        const float k0v = conv_k[DFF + j], k1v = conv_k[NUP + DFF + j], k2v = conv_k[2 * NUP + DFF + j], bv = conv_b[DFF + j];
        const float ga = k0g * g254 + k1g * g255 + k2g * g0 + bg, va = k0v * v254 + k1v * v255 + k2v * v0 + bv;
        const float gb = k0g * g255 + k1g * g0 + k2g * g1 + bg, vb = k0v * v255 + k1v * v0 + k2v * v1 + bv;
        ACT[((size_t)pmA * 256 + 255) * DFF + j] = pg8::bf1(ga / (1.0f + __expf(-ga)) * va);
        ACT[((size_t)pmB * 256) * DFF + j] = pg8::bf1(gb / (1.0f + __expf(-gb)) * vb);
    }
#endif
    GRID_BAR();
#if PH8
    {
        pg8::Gemm g{ACT, WdownT, DFF, DFF, DFF, 0}; pg8::PanelOrder S; S.init(MROWS, DM, G, bx);
        pg8::EpiGateBf16 E{AM, mod + 5 * DM};
        MidBar MB{lds, S.fast ? 1 : -1};
        pg8::gemm_phase<pg8::EpiGateBf16, pg8::PanelOrder, true, true, MidBar>(lds, g, S, E, MB);
#define P9_ROW(row) { const float* xr = (row) < NCTX ? x_prompt + (size_t)(row) * DM : x_sample + (size_t)((row) - NCTX) * DM; \
        norm_row(xr, norm_f_g, nullptr, nullptr, nullptr, out + (size_t)(row) * DM, lane, Hb + (size_t)(row) * DM, AM + (size_t)(row) * DM); }
        if (S.fast && bx >= 128) {
            for (int row = (bx - 128) * 8 + wave; row < 64 * 256; row += 1024) P9_ROW(row)
        }
    }
#endif
    GRID_BAR();
#if PH9
    for (int row = (G == 256 ? 64 * 256 : 0) + gw; row < MROWS; row += NGW) P9_ROW(row)
#undef P9_ROW
#endif

}

#undef x_prompt
#undef x_sample
#undef cin
#undef cache_k
#undef cache_v
#undef c_ctx
#undef w_ada
#undef b_ada
#undef norm1_g
#undef w_in
#undef lam_q1
#undef lam_k1
#undef lam_q2
#undef lam_k2
#undef subln_g
#undef w_pool
#undef pool_scale
#undef w_out
#undef norm2_g
#undef w_up
#undef conv_k
#undef conv_b
#undef w_down
#undef norm_f_g
#undef out
#undef ws
#undef state_k
#undef state_v
#undef ctl
#undef mod
#undef rope
#undef WinT
#undef WoutT
#undef WupT
#undef WdownT
#undef WpoolT
#undef Hb
#undef Qb
#undef Kc
#undef Kl
#undef Vtc
#undef Vtl
#undef Pb
#undef Pooled
#undef AM
#undef ACT
#undef ebuf
extern "C" void kernel_launch(void* const* d_in, const int* in_sizes, int n_in, void* d_out, int out_size, void* d_ws, size_t ws_size, hipStream_t stream) {
    static int grid = 0;
    if (grid == 0) {
        if (n_in != 24 || ws_size < WS_END) { fprintf(stderr, "kernel_launch: unexpected n_in %d / ws_size %zu\n", n_in, ws_size); grid = -1; return; }
        int dev = 0, cus = 0, per_cu = 0;
        (void)hipGetDevice(&dev); (void)hipDeviceGetAttribute(&cus, hipDeviceAttributeMultiprocessorCount, dev);
        (void)hipFuncSetAttribute((const void*)fwd_kernel, hipFuncAttributeMaxDynamicSharedMemorySize, LDS_BYTES);
        (void)hipOccupancyMaxActiveBlocksPerMultiprocessor(&per_cu, (const void*)fwd_kernel, 512, LDS_BYTES);
        if (per_cu < 1) { fprintf(stderr, "kernel_launch: occupancy query returned %d\n", per_cu); per_cu = 1; }
        (void)hipGetLastError();
        grid = cus * 1;
    }
    if (grid < 0) return;
    (void)hipMemsetAsync((char*)d_ws + WS_CTL, 0, CTL_ZERO_BYTES, stream);
    Args a{};
    for (int i = 0; i < 24; ++i) a.in[i] = (const float*)d_in[i];
    a.outp = (float*)d_out; a.wsp = (unsigned char*)d_ws;
    void* kargs[] = {&a};
    hipError_t e = hipLaunchCooperativeKernel((const void*)fwd_kernel, dim3(grid), dim3(512), kargs, LDS_BYTES, stream);
    if (e != hipSuccess) fprintf(stderr, "kernel_launch: cooperative launch failed: %s (grid %d)\n", hipGetErrorString(e), grid);
}
```

```cpp
#include <hip/hip_runtime.h>
#include <hip/hip_cooperative_groups.h>
#include <cstdio>
#include <cstdint>
namespace cg = cooperative_groups;
#ifndef PH0
#define PH0 1
#endif
#ifndef PH1
#define PH1 1
#endif
#ifndef PH2
#define PH2 1
#endif
#ifndef PH3
#define PH3 1
#endif
#ifndef PH3B
#define PH3B 1
#endif
#ifndef PH4
#define PH4 1
#endif
#ifndef PH5
#define PH5 1
#endif
#ifndef PH6
#define PH6 1
#endif
#ifndef PH7
#define PH7 1
#endif
#ifndef PH8
#define PH8 1
#endif
#ifndef PH9
#define PH9 1
#endif

constexpr int DM = 2048, NCTX = 4096, NLAT = 16384, MROWS = 20480, DIN = 4096, DFF = 5504, NUP = 11008, DATT = 1024;
constexpr int TCTX = 256, TLAT = 2048, PAST = 512, TALL = 2560, NMOD = 12288;
constexpr float EPS = 1e-6f;
constexpr float QSCALE = 0.125f * 1.4426950408889634f;
namespace pg8 {
#define PG8_LAS __attribute__((address_space(3)))
typedef unsigned short bf16_t;
typedef short bf16x8 __attribute__((ext_vector_type(8)));
typedef float f32x4 __attribute__((ext_vector_type(4)));
typedef unsigned u32x4 __attribute__((ext_vector_type(4)));
constexpr int BM = 256, BK = 64, HALF = 128, HTB = HALF * BK * 2  , STAGE_BYTES = 8 * HTB, NXCD = 8, WGM = 4;

__host__ __device__ __forceinline__ int lds_byte(int r, int c) { const int st = (r >> 4) * 2 + (c >> 5), rr = r & 15, cc = c & 31, ob = rr * 64 + cc * 2; return st * 1024 + (ob ^ (((ob >> 9) & 1) << 5)); }
__host__ __device__ __forceinline__ void stage_rc(int b, int& R, int& C) { const int st = b / 1024, sb = b % 1024, swz = sb ^ (((sb >> 9) & 1) << 5); R = (st >> 1) * 16 + swz / 64; C = (st & 1) * 32 + (swz % 64) / 2; }
__host__ __device__ __forceinline__ int perm32(int rho) { const int n = rho >> 4, i = rho & 15; return 8 * (i >> 2) + 4 * n + (i & 3); }

struct Unit { int pm, pn; };
struct Gemm { const bf16_t* A; const bf16_t* Bt; int lda, ldb, K, acol; };

struct StaticOrder {
    int nM, nN, nwg, G, c;
    __host__ __device__ void init(int M, int N, int G_, int c_) { nM = M / BM; nN = N / BM; nwg = nM * nN; G = G_; c = c_; }
    __host__ __device__ bool next(int i, Unit& u) const {
        const long L = (long)i * G + c; if (L >= nwg) return false;
        int wgid = (int)L; { const int q = nwg / NXCD, r = nwg % NXCD, xcd = wgid % NXCD, off = wgid / NXCD; wgid = (xcd < r ? xcd * (q + 1) : r * (q + 1) + (xcd - r) * q) + off; }
        const int nig = WGM * nN, gid = wgid / nig, fm = gid * WGM, gsz = (nM - fm) < WGM ? (nM - fm) : WGM;
        u.pm = fm + ((wgid % nig) % gsz); u.pn = (wgid % nig) / gsz; return true;
    }
    __device__ __forceinline__ void a_ready(const Unit&) const {}
    __device__ __forceinline__ void done(const Unit&) const {}
};

struct PanelOrder {
    StaticOrder so; bool fast;
    __host__ __device__ void init(int M, int N, int G_, int c_) { so.init(M, N, G_, c_); fast = (G_ == 256 && so.nN == 8 && so.nM == 80); }
    __host__ __device__ bool next(int i, Unit& u) const {
        if (!fast) return so.next(i, u);
        const int c = so.c, xcd = c & 7, j = c >> 3;
        if (i < 2) { u.pm = i * 32 + xcd * 4 + (j & 3); u.pn = j >> 2; return true; }
        if (i == 2 && c < 128) { u.pm = 64 + xcd * 2 + (j & 1); u.pn = j >> 1; return true; }
        return false;
    }
    __device__ __forceinline__ void a_ready(const Unit&) const {}
    __device__ __forceinline__ void done(const Unit&) const {}
};

struct NoMid { __device__ __forceinline__ void operator()(int) const {} };
template <class Epi, class Sched, bool ALIGN_EPI = false, bool SP2 = false, class Mid = NoMid>
__device__ __forceinline__ void gemm_phase(PG8_LAS unsigned char* lds, const Gemm g, const Sched& S, const Epi& E, const Mid& MH = Mid()) {
    int tid_ = threadIdx.x; asm volatile("" : "+v"(tid_));
    const int tid = tid_, wid = __builtin_amdgcn_readfirstlane(tid >> 6), lane = tid & 63, wr = wid >> 2, wc = wid & 3, fr = lane & 15, fq = lane >> 4;
    const int K = g.K, nt = K / BK;
    unsigned voffA[2], voffB[2];
#pragma unroll
    for (int i = 0; i < 2; ++i) { int R, C; stage_rc(tid * 16 + i * 8192, R, C); const int Rb = Epi::PERM ? ((R & ~31) + perm32(R & 31)) : R;
        voffA[i] = (unsigned)(R * g.lda + C) * 2u; voffB[i] = (unsigned)(Rb * g.ldb + C) * 2u; }
    const size_t kstep = (size_t)(BK * 2);
    const size_t hstepA = (size_t)HALF * g.lda * 2, hstepB = (size_t)HALF * g.ldb * 2;
    const size_t tstepA = 2 * hstepA, tstepB = 2 * hstepB, acolb = (size_t)g.acol * 2;
    const unsigned ldsw = (unsigned)wid * 1024u;
    const int aoff = lds_byte(wr * 64 + fr, fq * 8), boff = lds_byte(wc * 32 + fr, fq * 8);
#define PG8_SA(b, h) (((b) * 2 + (h)) * HTB)
#define PG8_SB(b, h) ((4 + (b) * 2 + (h)) * HTB)
#define PG8_STAGE(bufoff, gbase, voff) do { _Pragma("unroll") for (int _i = 0; _i < 2; ++_i) \
        __builtin_amdgcn_global_load_lds((const unsigned*)((const char*)(gbase) + (voff)[_i]), (PG8_LAS unsigned*)(lds + (bufoff) + ldsw + _i * 8192), 16, 0, 0); } while (0)
#define PG8_LDA(dst, b, h) do { _Pragma("unroll") for (int m = 0; m < 4; ++m) _Pragma("unroll") for (int k = 0; k < 2; ++k) dst[m][k] = *(const PG8_LAS bf16x8*)(lds + PG8_SA(b, h) + aoff + m * 2048 + k * 1024); } while (0)
#define PG8_LDB(dst, b, h) do { _Pragma("unroll") for (int n = 0; n < 2; ++n) _Pragma("unroll") for (int k = 0; k < 2; ++k) dst[n][k] = *(const PG8_LAS bf16x8*)(lds + PG8_SB(b, h) + boff + n * 2048 + k * 1024); } while (0)
#define PG8_MMA(ai, bj, At, Bt) do { __builtin_amdgcn_s_setprio(1); _Pragma("unroll") for (int m = 0; m < 4; ++m) _Pragma("unroll") for (int n = 0; n < 2; ++n) _Pragma("unroll") for (int k = 0; k < 2; ++k) \
        acc[ai][bj][m][n] = __builtin_amdgcn_mfma_f32_16x16x32_bf16(Bt[n][k], At[m][k], acc[ai][bj][m][n], 0, 0, 0); __builtin_amdgcn_s_setprio(0); } while (0)
#define PG8_WAIT_V(n) asm volatile("s_waitcnt vmcnt(" #n ")" ::: "memory")
#define PG8_WAIT_L(n) asm volatile("s_waitcnt lgkmcnt(" #n ")" ::: "memory")
#define PG8_BAR __builtin_amdgcn_s_barrier()
#define PG8_SCHED __builtin_amdgcn_sched_barrier(0)
    Unit cur, nxt; int ui = 0;
    if (!S.next(0, cur)) return;
    f32x4 acc[2][2][4][2];
#pragma unroll
    for (int a = 0; a < 2; ++a)
#pragma unroll
        for (int b = 0; b < 2; ++b)
#pragma unroll
            for (int m = 0; m < 4; ++m)
#pragma unroll
                for (int n = 0; n < 2; ++n) acc[a][b][m][n] = (f32x4){0.f, 0.f, 0.f, 0.f};
    bf16x8 At[4][2], B0[2][2], B1[2][2];
    const char* cA = (const char*)g.A + (size_t)cur.pm * tstepA + (size_t)cur.pn * acolb; const char* cB = (const char*)g.Bt + (size_t)cur.pn * tstepB;
    S.a_ready(cur);
    if constexpr (SP2) {
        PG8_STAGE(PG8_SB(0, 0), cB, voffB); PG8_STAGE(PG8_SB(0, 1), cB + hstepB, voffB); PG8_STAGE(PG8_SA(0, 0), cA, voffA); PG8_STAGE(PG8_SA(0, 1), cA + hstepA, voffA);
        if (wr == 1) PG8_BAR;
        PG8_WAIT_V(2); PG8_BAR;
        PG8_STAGE(PG8_SB(1, 0), cB + kstep, voffB); PG8_STAGE(PG8_SA(1, 0), cA + kstep, voffA); PG8_STAGE(PG8_SB(1, 1), cB + hstepB + kstep, voffB);
        PG8_WAIT_V(6); PG8_BAR;
    } else {
        PG8_STAGE(PG8_SB(0, 0), cB, voffB); PG8_STAGE(PG8_SA(0, 0), cA, voffA); PG8_STAGE(PG8_SB(0, 1), cB + hstepB, voffB); PG8_STAGE(PG8_SA(0, 1), cA + hstepA, voffA);
        if (wr == 1) PG8_BAR;
        PG8_WAIT_V(4); PG8_BAR;
        PG8_STAGE(PG8_SB(1, 0), cB + kstep, voffB); PG8_STAGE(PG8_SA(1, 0), cA + kstep, voffA); PG8_STAGE(PG8_SB(1, 1), cB + hstepB + kstep, voffB);
        PG8_WAIT_V(6); PG8_BAR;
    }
    for (;;) {
        const bool has_next = S.next(ui + 1, nxt);
        const char* nA = has_next ? (const char*)g.A + (size_t)nxt.pm * tstepA + (size_t)nxt.pn * acolb : cA; const char* nB = has_next ? (const char*)g.Bt + (size_t)nxt.pn * tstepB : cB;
        for (int t = 0; t < nt; t += 2) {
            const bool last = (t == nt - 2);
            const char* a1 = cA + (size_t)(t + 1) * kstep;
            const char* a2 = last ? nA : cA + (size_t)(t + 2) * kstep; const char* b2 = last ? nB : cB + (size_t)(t + 2) * kstep;
            const char* a3 = a2 + kstep; const char* b3 = b2 + kstep;
            if (last && has_next) S.a_ready(nxt);
            if constexpr (SP2) {
            PG8_LDB(B0, 0, 0); PG8_LDB(B1, 0, 1); PG8_SCHED; PG8_LDA(At, 0, 0); PG8_STAGE(PG8_SA(1, 1), a1 + hstepA, voffA);
            PG8_WAIT_V(8); PG8_WAIT_L(0); PG8_BAR; PG8_MMA(0, 0, At, B0); PG8_MMA(0, 1, At, B1); PG8_BAR; PG8_SCHED;
            PG8_LDA(At, 0, 1); PG8_STAGE(PG8_SB(0, 0), b2, voffB); PG8_STAGE(PG8_SB(0, 1), b2 + hstepB, voffB); PG8_STAGE(PG8_SA(0, 0), a2, voffA);
            PG8_WAIT_V(8); PG8_WAIT_L(0); PG8_BAR; PG8_MMA(1, 0, At, B0); PG8_MMA(1, 1, At, B1); PG8_BAR; PG8_SCHED;
            PG8_LDB(B0, 1, 0); PG8_LDB(B1, 1, 1); PG8_SCHED; PG8_LDA(At, 1, 0); PG8_STAGE(PG8_SA(0, 1), a2 + hstepA, voffA);
            PG8_WAIT_V(8); PG8_WAIT_L(0); PG8_BAR; PG8_MMA(0, 0, At, B0); PG8_MMA(0, 1, At, B1); PG8_BAR; PG8_SCHED;
            PG8_LDA(At, 1, 1); PG8_STAGE(PG8_SB(1, 0), b3, voffB); PG8_STAGE(PG8_SB(1, 1), b3 + hstepB, voffB); PG8_STAGE(PG8_SA(1, 0), a3, voffA);
            PG8_WAIT_V(8); PG8_WAIT_L(0); PG8_BAR; PG8_MMA(1, 0, At, B0); PG8_MMA(1, 1, At, B1); PG8_BAR; PG8_SCHED;
            } else {
            PG8_LDB(B0, 0, 0); PG8_SCHED; PG8_LDA(At, 0, 0); PG8_STAGE(PG8_SA(1, 1), a1 + hstepA, voffA);
            PG8_WAIT_L(8); PG8_BAR; PG8_WAIT_L(0); PG8_MMA(0, 0, At, B0); PG8_BAR; PG8_SCHED;
            PG8_LDB(B1, 0, 1); PG8_STAGE(PG8_SB(0, 0), b2, voffB);
            PG8_BAR; PG8_WAIT_L(0); PG8_MMA(0, 1, At, B1); PG8_BAR;
            PG8_LDA(At, 0, 1); PG8_STAGE(PG8_SA(0, 0), a2, voffA);
            PG8_BAR; PG8_WAIT_L(0); PG8_MMA(1, 0, At, B0); PG8_BAR; PG8_SCHED;
            PG8_STAGE(PG8_SB(0, 1), b2 + hstepB, voffB);
            PG8_WAIT_V(6); PG8_BAR; PG8_MMA(1, 1, At, B1); PG8_BAR;
            PG8_LDB(B0, 1, 0); PG8_SCHED; PG8_LDA(At, 1, 0); PG8_STAGE(PG8_SA(0, 1), a2 + hstepA, voffA);
            PG8_WAIT_L(8); PG8_BAR; PG8_WAIT_L(0); PG8_MMA(0, 0, At, B0); PG8_BAR; PG8_SCHED;
            PG8_LDB(B1, 1, 1); PG8_STAGE(PG8_SB(1, 0), b3, voffB);
            PG8_BAR; PG8_WAIT_L(0); PG8_MMA(0, 1, At, B1); PG8_BAR;
            PG8_LDA(At, 1, 1); PG8_STAGE(PG8_SA(1, 0), a3, voffA);
            PG8_BAR; PG8_WAIT_L(0); PG8_MMA(1, 0, At, B0); PG8_BAR; PG8_SCHED;
            PG8_STAGE(PG8_SB(1, 1), b3 + hstepB, voffB);
            PG8_WAIT_V(6); PG8_BAR; PG8_MMA(1, 1, At, B1); PG8_BAR;
            }
        }
        if constexpr (ALIGN_EPI) { if (wr == 0) PG8_BAR; }
        if constexpr (!Epi::AFTER_DRAIN) { E(acc, cur, wr, wc, fr, fq); S.done(cur); }
        MH(ui);
        if (!has_next) break;
#pragma unroll
        for (int a = 0; a < 2; ++a)
#pragma unroll
            for (int b = 0; b < 2; ++b)
#pragma unroll
                for (int m = 0; m < 4; ++m)
#pragma unroll
                    for (int n = 0; n < 2; ++n) acc[a][b][m][n] = (f32x4){0.f, 0.f, 0.f, 0.f};
        cur = nxt; cA = nA; cB = nB; ++ui;
        if constexpr (ALIGN_EPI) { if (wr == 1) PG8_BAR; }
    }
    PG8_WAIT_V(0);
    if constexpr (!ALIGN_EPI) { if (wr == 0) PG8_BAR; }
    PG8_BAR;
    if constexpr (Epi::AFTER_DRAIN) { E.fused(acc, cur, wr, wc, fr, fq, lds, wid, lane); S.done(cur); }
#undef PG8_SA
#undef PG8_SB
#undef PG8_STAGE
#undef PG8_LDA
#undef PG8_LDB
#undef PG8_MMA
#undef PG8_WAIT_V
#undef PG8_WAIT_L
#undef PG8_BAR
#undef PG8_SCHED
}
typedef float f32x2 __attribute__((ext_vector_type(2)));
typedef __bf16 bf16x2_t __attribute__((ext_vector_type(2)));
typedef unsigned u32x2 __attribute__((ext_vector_type(2)));
__device__ __forceinline__ unsigned cvtpk(float lo, float hi) { f32x2 v = {lo, hi}; bf16x2_t b = __builtin_convertvector(v, bf16x2_t); return __builtin_bit_cast(unsigned, b); }
__device__ __forceinline__ u32x2 pack4(f32x4 v) { u32x2 w; w.x = cvtpk(v[0], v[1]); w.y = cvtpk(v[2], v[3]); return w; }
__device__ __forceinline__ unsigned short bf1(float v) { return (unsigned short)(cvtpk(v, 0.f) & 0xffffu); }

struct EpiInProj {
    static constexpr bool PERM = false, AFTER_DRAIN = false;
    bf16_t *Q, *Kc, *Kl, *Vtc, *Vtl, *P; float *sk, *sv; const float* rope;
    __device__ __forceinline__ void operator()(const f32x4 (&acc)[2][2][4][2], const Unit& u, int wr, int wc, int fr, int fq) const {
        const int kind = u.pn >> 2; const bool lat = u.pm >= 16; const int pml = u.pm - 16;
        const int b = lat ? (pml >> 3) : u.pm; const int t0 = lat ? (pml & 7) * 256 : 0; const int cb = (u.pn & 3) * 256;
#pragma unroll
        for (int ai = 0; ai < 2; ++ai)
#pragma unroll
            for (int m = 0; m < 4; ++m) {
                const int tl = ai * HALF + wr * 64 + m * 16 + fr; const int t = t0 + tl; const size_t row = (size_t)u.pm * BM + tl;
                f32x4 c0v = {1.f, 1.f, 1.f, 1.f}, s0v = {0.f, 0.f, 0.f, 0.f};
                if (kind <= 1 && lat) { const int pos = (wc & 1) ? (t & 63) : (t >> 6); const f32x4* rp = (const f32x4*)(rope + (pos * 16 + fq * 4) * 2);
                    const f32x4 a = rp[0], bq = rp[1]; c0v = (f32x4){a[0], a[2], bq[0], bq[2]}; s0v = (f32x4){a[1], a[3], bq[1], bq[3]}; }
#pragma unroll
                for (int bj = 0; bj < 2; ++bj) {
                    f32x4 v0 = acc[ai][bj][m][0], v1 = acc[ai][bj][m][1];
                    const int c0 = cb + bj * HALF + wc * 32 + fq * 4;
                    if (kind <= 1 && lat) { const f32x4 r0 = v0 * c0v - v1 * s0v, r1 = v1 * c0v + v0 * s0v; v0 = r0; v1 = r1; }
                    if (kind == 0) { v0 = v0 * QSCALE; v1 = v1 * QSCALE; bf16_t* o = Q + row * DATT + c0; *(u32x2*)o = pack4(v0); *(u32x2*)(o + 16) = pack4(v1); }
                    else if (kind == 1) {
                        if (!lat) { float* so = sk + row * DATT + c0; *(f32x4*)so = v0; *(f32x4*)(so + 16) = v1; bf16_t* o = Kc + row * DATT + c0; *(u32x2*)o = pack4(v0); *(u32x2*)(o + 16) = pack4(v1); }
                        else { bf16_t* o = Kl + ((size_t)b * TALL + PAST + t) * DATT + c0; *(u32x2*)o = pack4(v0); *(u32x2*)(o + 16) = pack4(v1); }
                    } else if (kind == 2) {
                        const int head = (u.pn & 3) * 2 + bj, dcol = wc * 32 + fq * 4;
                        if (!lat) { float* so = sv + row * DATT + c0; *(f32x4*)so = v0; *(f32x4*)(so + 16) = v1;
                            bf16_t* o = Vtc + ((size_t)(b * 8 + head) * 128 + dcol) * TCTX + t;
#pragma unroll
                            for (int i = 0; i < 4; ++i) { o[(size_t)i * TCTX] = bf1(v0[i]); o[(size_t)(i + 16) * TCTX] = bf1(v1[i]); } }
                        else { bf16_t* o = Vtl + ((size_t)(b * 8 + head) * 128 + dcol) * TALL + PAST + t;
#pragma unroll
                            for (int i = 0; i < 4; ++i) { o[(size_t)i * TALL] = bf1(v0[i]); o[(size_t)(i + 16) * TALL] = bf1(v1[i]); } }
                    } else { bf16_t* o = P + row * DATT + c0; *(u32x2*)o = pack4(v0); *(u32x2*)(o + 16) = pack4(v1); }
                }
            }
    }
};
struct EpiResid {
    static constexpr bool PERM = false, AFTER_DRAIN = false;
    const float *xa, *xb; float* out; const float* gate;
    __device__ __forceinline__ void operator()(const f32x4 (&acc)[2][2][4][2], const Unit& u, int wr, int wc, int fr, int fq) const {
        const int bidx = u.pm < 16 ? 8 : ((u.pm - 16) >> 3);
        const float* gp = gate + (size_t)bidx * NMOD + u.pn * BM + wc * 32 + fq * 4;
        f32x4 gv[2][2];
#pragma unroll
        for (int bj = 0; bj < 2; ++bj)
#pragma unroll
            for (int n = 0; n < 2; ++n) gv[bj][n] = *(const f32x4*)(gp + bj * HALF + n * 16);
#pragma unroll
        for (int ai = 0; ai < 2; ++ai)
#pragma unroll
            for (int m = 0; m < 4; ++m) {
                const size_t row = (size_t)u.pm * BM + ai * HALF + wr * 64 + m * 16 + fr;
                const float* xr = (row < (size_t)NCTX ? xa + row * DM : xb + (row - NCTX) * DM) + u.pn * BM + wc * 32 + fq * 4;
                float* orow = out + row * DM + u.pn * BM + wc * 32 + fq * 4;
#pragma unroll
                for (int bj = 0; bj < 2; ++bj)
#pragma unroll
                    for (int n = 0; n < 2; ++n) { const f32x4 xv = *(const f32x4*)(xr + bj * HALF + n * 16); *(f32x4*)(orow + bj * HALF + n * 16) = xv + gv[bj][n] * acc[ai][bj][m][n]; }
            }
    }
};
struct EpiGateBf16 {
    static constexpr bool PERM = false, AFTER_DRAIN = false;
    bf16_t* dst; const float* gate;
    __device__ __forceinline__ void operator()(const f32x4 (&acc)[2][2][4][2], const Unit& u, int wr, int wc, int fr, int fq) const {
        const int bidx = u.pm < 16 ? 8 : ((u.pm - 16) >> 3);
        const int cofs = u.pn * BM + wc * 32 + fq * 4;
        const float* gp = gate + (size_t)bidx * NMOD + cofs;
        bf16_t* o0 = dst + ((size_t)u.pm * BM + wr * 64 + fr) * DM + cofs;
#pragma unroll
        for (int bj = 0; bj < 2; ++bj)
#pragma unroll
            for (int n = 0; n < 2; ++n) {
                const f32x4 gv = *(const f32x4*)(gp + bj * HALF + n * 16);
#pragma unroll
                for (int ai = 0; ai < 2; ++ai)
#pragma unroll
                    for (int m = 0; m < 4; ++m) *(u32x2*)(o0 + (size_t)(ai * HALF + m * 16) * DM + bj * HALF + n * 16) = pack4(acc[ai][bj][m][n] * gv);
            }
    }
};
struct EpiPool {
    static constexpr bool PERM = false, AFTER_DRAIN = false;
    bf16_t* am; const float* scale;
    __device__ __forceinline__ void operator()(const f32x4 (&acc)[2][2][4][2], const Unit& u, int wr, int wc, int fr, int fq) const {
        const int cbase = u.pn * BM + wc * 32 + fq * 4;
        bf16_t* o0 = am + ((size_t)u.pm * BM + wr * 64 + fr) * DM + DATT + cbase;
#pragma unroll
        for (int bj = 0; bj < 2; ++bj)
#pragma unroll
            for (int n = 0; n < 2; ++n) {
                const f32x4 sv = *(const f32x4*)(scale + cbase + bj * HALF + n * 16);
#pragma unroll
                for (int ai = 0; ai < 2; ++ai)
#pragma unroll
                    for (int m = 0; m < 4; ++m) *(u32x2*)(o0 + (size_t)(ai * HALF + m * 16) * DM + bj * HALF + n * 16) = pack4(acc[ai][bj][m][n] * sv);
            }
    }
};
#define DPP_F(v, ctrl) __builtin_bit_cast(float, __builtin_amdgcn_update_dpp(0, __builtin_bit_cast(int, (v)), (ctrl), 0xf, 0xf, true))
#ifndef USE_DPP
#define USE_DPP 0
#endif
#if USE_DPP
__device__ __forceinline__ f32x4 dpp_shr1(f32x4 v)  { return (f32x4){DPP_F(v[0], 0x111), DPP_F(v[1], 0x111), DPP_F(v[2], 0x111), DPP_F(v[3], 0x111)}; }
__device__ __forceinline__ f32x4 dpp_shl1(f32x4 v)  { return (f32x4){DPP_F(v[0], 0x101), DPP_F(v[1], 0x101), DPP_F(v[2], 0x101), DPP_F(v[3], 0x101)}; }
__device__ __forceinline__ f32x4 dpp_shl15(f32x4 v) { return (f32x4){DPP_F(v[0], 0x10F), DPP_F(v[1], 0x10F), DPP_F(v[2], 0x10F), DPP_F(v[3], 0x10F)}; }
__device__ __forceinline__ f32x4 dpp_shr15(f32x4 v) { return (f32x4){DPP_F(v[0], 0x11F), DPP_F(v[1], 0x11F), DPP_F(v[2], 0x11F), DPP_F(v[3], 0x11F)}; }
#else
__device__ __forceinline__ f32x4 shfl_sel(f32x4 v, int src, bool ok) { f32x4 o;
#pragma unroll
    for (int i = 0; i < 4; ++i) { const float t = __shfl(v[i], src); o[i] = ok ? t : 0.f; } return o; }
__device__ __forceinline__ f32x4 dpp_shr1(f32x4 v)  { const int l = threadIdx.x & 63; return shfl_sel(v, l - 1, (l & 15) != 0); }
__device__ __forceinline__ f32x4 dpp_shl1(f32x4 v)  { const int l = threadIdx.x & 63; return shfl_sel(v, l + 1, (l & 15) != 15); }
__device__ __forceinline__ f32x4 dpp_shl15(f32x4 v) { const int l = threadIdx.x & 63; return shfl_sel(v, l + 15, (l & 15) == 0); }
__device__ __forceinline__ f32x4 dpp_shr15(f32x4 v) { const int l = threadIdx.x & 63; return shfl_sel(v, l - 15, (l & 15) == 15); }
#endif
__device__ __forceinline__ f32x4 silu_mul(f32x4 g, f32x4 v) {
    f32x4 o;
#pragma unroll
    for (int i = 0; i < 4; ++i) { const float e = __builtin_amdgcn_exp2f(-g[i] * 1.4426950408889634f); o[i] = g[i] * __builtin_amdgcn_rcpf(1.0f + e) * v[i]; }
    return o;
}
struct EpiUp {
    static constexpr bool PERM = false, AFTER_DRAIN = false;
    bf16_t* act; float* ebuf; const float* ck; const float* cbias; PG8_LAS float* xl;
    __device__ __forceinline__ void operator()(const f32x4 (&acc)[2][2][4][2], const Unit& u, int wr, int wc, int fr, int fq) const {
        const int colw = wc * 32 + fq * 4;
#pragma unroll
        for (int ai = 0; ai < 2; ++ai)
#pragma unroll
            for (int bj = 0; bj < 2; ++bj)
#pragma unroll
                for (int n = 0; n < 2; ++n) { const int col = bj * HALF + n * 16 + colw, rb = ai * 2 + wr;
                    if (fr == 0) *(PG8_LAS f32x4*)(xl + (rb * 2) * 256 + col) = acc[ai][bj][0][n];
                    if (fr == 15) *(PG8_LAS f32x4*)(xl + (rb * 2 + 1) * 256 + col) = acc[ai][bj][3][n]; }
        float* eb = ebuf + (size_t)u.pm * 4 * NUP + u.pn * BM + colw;
        if (wr == 0 && fr < 2) {
#pragma unroll
            for (int bj = 0; bj < 2; ++bj)
#pragma unroll
                for (int n = 0; n < 2; ++n) *(f32x4*)(eb + (size_t)fr * NUP + bj * HALF + n * 16) = acc[0][bj][0][n]; }
        if (wr == 1 && fr >= 14) {
#pragma unroll
            for (int bj = 0; bj < 2; ++bj)
#pragma unroll
                for (int n = 0; n < 2; ++n) *(f32x4*)(eb + (size_t)(fr - 12) * NUP + bj * HALF + n * 16) = acc[1][bj][3][n]; }
        asm volatile("s_waitcnt lgkmcnt(0)" ::: "memory"); __builtin_amdgcn_s_barrier(); asm volatile("" ::: "memory");
#pragma unroll
        for (int n = 0; n < 2; ++n) {
            const int gc = u.pn * HALF + n * 16 + colw;
            const f32x4 k0g = *(const f32x4*)(ck + gc), k1g = *(const f32x4*)(ck + NUP + gc), k2g = *(const f32x4*)(ck + 2 * NUP + gc), bg = *(const f32x4*)(cbias + gc);
            const f32x4 k0v = *(const f32x4*)(ck + DFF + gc), k1v = *(const f32x4*)(ck + NUP + DFF + gc), k2v = *(const f32x4*)(ck + 2 * NUP + DFF + gc), bv = *(const f32x4*)(cbias + DFF + gc);
#pragma unroll
            for (int ai = 0; ai < 2; ++ai) {
                const int rb = ai * 2 + wr; const f32x4 z4 = {0.f, 0.f, 0.f, 0.f};
                const int l_ = threadIdx.x & 63, srcR = (l_ & 48) | ((l_ - 1) & 15), srcL = (l_ & 48) | ((l_ + 1) & 15);
                int Rp[4] = {0, 0, 0, 0}, Lc[4], Ln[4] = {0, 0, 0, 0};
#pragma unroll
                for (int i = 0; i < 4; ++i) Lc[i] = __shfl((int)cvtpk(acc[ai][0][0][n][i], acc[ai][1][0][n][i]), srcL);
#pragma unroll
                for (int m = 0; m < 4; ++m) {
                    const f32x4 cg_ = acc[ai][0][m][n], cv_ = acc[ai][1][m][n];
                    int Rc[4];
#pragma unroll
                    for (int i = 0; i < 4; ++i) Rc[i] = __shfl((int)cvtpk(cg_[i], cv_[i]), srcR);
                    if (m < 3) {
#pragma unroll
                        for (int i = 0; i < 4; ++i) Ln[i] = __shfl((int)cvtpk(acc[ai][0][m < 3 ? m + 1 : 3][n][i], acc[ai][1][m < 3 ? m + 1 : 3][n][i]), srcL); }
                    f32x4 ug, uv, dg, dv;
#pragma unroll
                    for (int i = 0; i < 4; ++i) {
                        const unsigned up = (unsigned)(fr > 0 ? Rc[i] : Rp[i]), dn = (unsigned)(fr < 15 ? Lc[i] : Ln[i]);
                        ug[i] = __builtin_bit_cast(float, up << 16); uv[i] = __builtin_bit_cast(float, up & 0xffff0000u);
                        dg[i] = __builtin_bit_cast(float, dn << 16); dv[i] = __builtin_bit_cast(float, dn & 0xffff0000u);
                        Rp[i] = Rc[i]; Lc[i] = Ln[i];
                    }
                    if (m == 0 && fr == 0) { ug = z4; uv = z4; if (rb > 0) { ug = *(const PG8_LAS f32x4*)(xl + ((rb - 1) * 2 + 1) * 256 + n * 16 + colw); uv = *(const PG8_LAS f32x4*)(xl + ((rb - 1) * 2 + 1) * 256 + HALF + n * 16 + colw); } }
                    if (m == 3 && fr == 15) { dg = z4; dv = z4; if (rb < 3) { dg = *(const PG8_LAS f32x4*)(xl + ((rb + 1) * 2) * 256 + n * 16 + colw); dv = *(const PG8_LAS f32x4*)(xl + ((rb + 1) * 2) * 256 + HALF + n * 16 + colw); } }
                    const f32x4 gg = k0g * ug + k1g * cg_ + k2g * dg + bg, vv = k0v * uv + k1v * cv_ + k2v * dv + bv;
                    const size_t row = (size_t)u.pm * BM + ai * HALF + wr * 64 + m * 16 + fr;
                    *(u32x2*)(act + row * DFF + gc) = pack4(silu_mul(gg, vv));
                }
            }
        }
    }
};
}
#define LAS __attribute__((address_space(3)))
typedef unsigned short bf16;
typedef float f32x4 __attribute__((ext_vector_type(4)));
typedef float f32x16 __attribute__((ext_vector_type(16)));
typedef short bf16x8 __attribute__((ext_vector_type(8)));
typedef short s16x4 __attribute__((ext_vector_type(4)));
typedef unsigned u32x4 __attribute__((ext_vector_type(4)));
typedef unsigned u32x2 __attribute__((ext_vector_type(2)));
using pg8::cvtpk; using pg8::pack4;
__device__ __forceinline__ float wave_sum(float v) {
#pragma unroll
    for (int o = 1; o < 64; o <<= 1) v += __shfl_xor(v, o);
    return v;
}
__device__ __forceinline__ float bf_lo(unsigned w) { return __builtin_bit_cast(float, w << 16); }
__device__ __forceinline__ float bf_hi(unsigned w) { return __builtin_bit_cast(float, w & 0xffff0000u); }
__device__ __forceinline__ float half_max(float v) { return fmaxf(v, __shfl_xor(v, 32)); }
__device__ __forceinline__ float half_sum(float v) { return v + __shfl_xor(v, 32); }

constexpr size_t MiB = 1u << 20;
constexpr size_t WS_CTL = 0, CTL_ZERO_BYTES = 32768;
constexpr size_t WS_MOD = 1 * MiB, WS_ROPE = 2 * MiB;
constexpr size_t WS_WIN = 4 * MiB, WS_WOUT = 20 * MiB, WS_WUP = 28 * MiB, WS_WDOWN = 71 * MiB, WS_WPOOL = 93 * MiB;
constexpr size_t WS_H = 94 * MiB, WS_Q = 174 * MiB, WS_KC = 214 * MiB, WS_KL = 222 * MiB, WS_VTC = 262 * MiB, WS_VTL = 270 * MiB, WS_P = 310 * MiB, WS_POOLED = 350 * MiB;
constexpr size_t WS_AM = 390 * MiB, WS_EBUF = 470 * MiB, WS_ACT = 174 * MiB, WS_END = 484 * MiB;
static_assert(WS_ACT + (size_t)MROWS * DFF * 2 <= WS_AM, "act overlay");
static_assert(WS_EBUF + (size_t)80 * 4 * NUP * 4 <= WS_END, "ebuf");
constexpr int RING_BYTES = 131072, XL_OFF = RING_BYTES, LDS_BYTES = 147456;

__device__ __forceinline__ void transpose_item(const float* W, int ldw, int k0, int n0, bf16* WT, int ldt, int drow0, LAS float* scr, int lane) {
#pragma unroll 8
    for (int i = 0; i < 32; ++i) { const int kk = 2 * i + (lane >> 5); scr[kk * 33 + (lane & 31)] = W[(size_t)(k0 + kk) * ldw + n0 + (lane & 31)]; }
    asm volatile("s_waitcnt lgkmcnt(0)" ::: "memory");
    const int c = lane & 7;
#pragma unroll
    for (int j = 0; j < 4; ++j) { const int n = (lane >> 3) + 8 * j; const LAS float* s = scr + (8 * c) * 33 + n;
        u32x4 o; o.x = cvtpk(s[0 * 33], s[1 * 33]); o.y = cvtpk(s[2 * 33], s[3 * 33]); o.z = cvtpk(s[4 * 33], s[5 * 33]); o.w = cvtpk(s[6 * 33], s[7 * 33]);
        *(u32x4*)(WT + (size_t)(drow0 + n) * ldt + k0 + 8 * c) = o; }
    asm volatile("s_waitcnt lgkmcnt(0)" ::: "memory");
}
constexpr int IT_WIN = (DM / 64) * (DIN / 32), IT_WOUT = (DM / 64) * (DM / 32), IT_WUP = (DM / 64) * (NUP / 32), IT_WDOWN = (DFF / 64) * (DM / 32), IT_WPOOL = 4 * 4 * 8,
              IT_CV = 8 * (PAST / 64) * (DATT / 32), IT_CK = 8 * PAST;
constexpr int IT_TOTAL = IT_WIN + IT_WOUT + IT_WUP + IT_WPOOL + IT_CV + IT_CK + IT_WDOWN;

struct Args { const float* in[24]; float* outp; unsigned char* wsp; };

__device__ __forceinline__ void norm_row(const float* xrow, const float* g, const float* sc, const float* sh, bf16* outb, float* outf, int lane, const bf16* addb = nullptr, const bf16* addc = nullptr) {
    const f32x4* xr = (const f32x4*)xrow + lane;
    f32x4 v[8]; float s = 0.f;
#pragma unroll
    for (int j = 0; j < 8; ++j) { v[j] = xr[64 * j];
        if (addb) { const u32x2 d_ = ((const u32x2*)addb + lane)[64 * j]; v[j] += (f32x4){bf_lo(d_.x), bf_hi(d_.x), bf_lo(d_.y), bf_hi(d_.y)}; }
        if (addc) { const u32x2 d_ = ((const u32x2*)addc + lane)[64 * j]; v[j] += (f32x4){bf_lo(d_.x), bf_hi(d_.x), bf_lo(d_.y), bf_hi(d_.y)}; }
        s += (v[j].x * v[j].x + v[j].y * v[j].y) + (v[j].z * v[j].z + v[j].w * v[j].w); }
    const float rstd = 1.0f / sqrtf(wave_sum(s) * (1.0f / DM) + EPS);
#pragma unroll
    for (int j = 0; j < 8; ++j) {
        const int c = 4 * lane + 256 * j;
        f32x4 y = v[j] * rstd * *(const f32x4*)(g + c);
        if (sc) y = y * (1.0f + *(const f32x4*)(sc + c)) + *(const f32x4*)(sh + c);
        if (outb) *(u32x2*)(outb + c) = pack4(y); else *(f32x4*)(outf + c) = y;
    }
}

template <int HW> __device__ __forceinline__ void pool_item(const bf16* base, bf16* obase, int t0, int T) {
    constexpr int NR = 7 + 2 * HW;
    u32x4 rows[NR];
#pragma unroll
    for (int j = 0; j < NR; ++j) { const int tt = t0 - HW + j; rows[j] = (tt >= 0 && tt < T) ? *(const u32x4*)(base + (size_t)tt * DATT) : (u32x4){0u, 0u, 0u, 0u}; }
    float s[8];
#pragma unroll
    for (int i = 0; i < 8; ++i) s[i] = 0.f;
#define POOL_ADD(SGN, v_) { s[0] SGN bf_lo(v_.x); s[1] SGN bf_hi(v_.x); s[2] SGN bf_lo(v_.y); s[3] SGN bf_hi(v_.y); s[4] SGN bf_lo(v_.z); s[5] SGN bf_hi(v_.z); s[6] SGN bf_lo(v_.w); s[7] SGN bf_hi(v_.w); }
#pragma unroll
    for (int j = 0; j < 2 * HW; ++j) POOL_ADD(+=, rows[j])
#pragma unroll
    for (int i = 0; i < 8; ++i) {
        const int t = t0 + i, lo = max(t - HW, 0), hi = min(t + HW, T); const float ic = 1.0f / (float)(hi - lo); const u32x4 ov = rows[i + HW];
        u32x4 w; w.x = cvtpk(s[0] * ic - bf_lo(ov.x), s[1] * ic - bf_hi(ov.x)); w.y = cvtpk(s[2] * ic - bf_lo(ov.y), s[3] * ic - bf_hi(ov.y));
        w.z = cvtpk(s[4] * ic - bf_lo(ov.z), s[5] * ic - bf_hi(ov.z)); w.w = cvtpk(s[6] * ic - bf_lo(ov.w), s[7] * ic - bf_hi(ov.w));
        *(u32x4*)(obase + (size_t)t * DATT) = w;
        if (i < 7) { POOL_ADD(+=, rows[i + 2 * HW]) POOL_ADD(-=, rows[i]) }
    }
#undef POOL_ADD
}

namespace att {
constexpr int KSTRB = 272, VSTRB = 144, KBYTES = 64 * KSTRB, VBYTES = 128 * VSTRB, V_OFF = 2 * KBYTES, OX_OFF = 0;
static_assert(V_OFF + 3 * VBYTES <= 131072 && 65536 <= 131072, "attention LDS");
__device__ __forceinline__ int crow(int r, int hi) { return (r & 3) + 8 * (r >> 2) + 4 * hi; }
__device__ __forceinline__ void pv_tile(f32x16 (&o)[4], LAS unsigned char* vbase, const bf16x8 (&pb)[4]) {
#pragma unroll
    for (int ks = 0; ks < 4; ++ks) {
        bf16x8 vf[4];
#pragma unroll
        for (int d = 0; d < 4; ++d) vf[d] = *(const LAS bf16x8*)(vbase + d * 32 * VSTRB + ks * 32);
#pragma unroll
        for (int d = 0; d < 4; ++d) o[d] = __builtin_amdgcn_mfma_f32_32x32x16_bf16(vf[d], pb[ks], o[d], 0, 0, 0);
    }
}
__device__ __forceinline__ void unit(LAS unsigned char* lds, const bf16* Qp, const bf16* Kg, const bf16* Vtg, int tall, int nt, bf16* Op, float lam, const float* subg) {
    const int tid = threadIdx.x, lane = tid & 63, r = lane & 31, hi = lane >> 5, wid = __builtin_amdgcn_readfirstlane(tid >> 6), rg = wid & 3, mp = wid >> 2;
    bf16x8 qf[4];
    { const bf16* qp = Qp + (size_t)(rg * 32 + r) * DATT + mp * 64 + hi * 8;
#pragma unroll
      for (int s = 0; s < 4; ++s) qf[s] = *(const bf16x8*)(qp + 16 * s); }
    f32x16 o[4];
#pragma unroll
    for (int d = 0; d < 4; ++d)
#pragma unroll
        for (int i = 0; i < 16; ++i) o[d][i] = 0.f;
    float m_run = 0.f, l_run = 0.f;
    const bf16* ksrc[2]; const bf16* vsrc[2]; int kdst[2], vdst[2];
#pragma unroll
    for (int i = 0; i < 2; ++i) { const int id = tid + 512 * i; ksrc[i] = Kg + (size_t)(id >> 4) * DATT + (id & 15) * 8; kdst[i] = (id >> 4) * KSTRB + (id & 15) * 16;
        vsrc[i] = Vtg + (size_t)(id >> 3) * tall + (id & 7) * 8; vdst[i] = V_OFF + (id >> 3) * VSTRB + ((id & 7) >> 1) * 32 + (id & 1) * 8; }
    u32x4 kr[2], vr[2];
#pragma unroll
    for (int i = 0; i < 2; ++i) { kr[i] = *(const u32x4*)ksrc[i]; vr[i] = *(const u32x4*)vsrc[i]; }
#pragma unroll
    for (int i = 0; i < 2; ++i) { *(LAS u32x4*)(lds + kdst[i]) = kr[i]; *(LAS u32x2*)(lds + vdst[i]) = (u32x2){vr[i].x, vr[i].y}; *(LAS u32x2*)(lds + vdst[i] + 16) = (u32x2){vr[i].z, vr[i].w}; }
    __syncthreads();
    const int koff = r * KSTRB + (mp * 64 + hi * 8) * 2, voff = V_OFF + r * VSTRB + hi * 16;
    bf16x8 pb[4];
#pragma unroll
    for (int i = 0; i < 4; ++i) pb[i] = (bf16x8){0, 0, 0, 0, 0, 0, 0, 0};
    int vcur = 0, vprev = 0;
    for (int t = 0; t < nt; ++t) {
        const int kcur = (t & 1) * KBYTES, knxt = KBYTES - kcur, vnxt = (vcur == 2 * VBYTES) ? 0 : vcur + VBYTES;
        if (t + 1 < nt) {
#pragma unroll
            for (int i = 0; i < 2; ++i) { kr[i] = *(const u32x4*)(ksrc[i] + (size_t)(t + 1) * 64 * DATT); vr[i] = *(const u32x4*)(vsrc[i] + (t + 1) * 64); }
        }
        f32x16 p0, p1;
#define ATT_QK(C0) { _Pragma("unroll") for (int i = 0; i < 16; ++i) { p0[i] = 0.f; p1[i] = 0.f; } _Pragma("unroll") for (int s = 0; s < 4; ++s) { \
            const bf16x8 a0 = *(const LAS bf16x8*)(lds + kcur + koff + s * 32), a1 = *(const LAS bf16x8*)(lds + kcur + koff + 32 * KSTRB + s * 32); \
            p0 = __builtin_amdgcn_mfma_f32_32x32x16_bf16(a0, qf[s], p0, 0, 0, 0); p1 = __builtin_amdgcn_mfma_f32_32x32x16_bf16(a1, qf[s], p1, 0, 0, 0); } }
#define ATT_ROWMAX(mx) { mx = fmaxf(p0[0], p1[0]); _Pragma("unroll") for (int i = 1; i < 16; ++i) mx = fmaxf(mx, fmaxf(p0[i], p1[i])); mx = half_max(mx); }
        float rs;
        for (bool redo = false;;) {
            ATT_QK(0)
            if (t == 0 || redo) {
                float mx; ATT_ROWMAX(mx)
                if (t != 0) { mx = fmaxf(mx - m_run, 0.f); const float alpha = __builtin_amdgcn_exp2f(-mx); l_run *= alpha;
#pragma unroll
                    for (int d = 0; d < 4; ++d)
#pragma unroll
                        for (int i = 0; i < 16; ++i) o[d][i] *= alpha; }
                m_run += mx;
            }
            rs = 0.f;
#pragma unroll
            for (int i = 0; i < 16; ++i) { p0[i] = __builtin_amdgcn_exp2f(p0[i] - m_run); p1[i] = __builtin_amdgcn_exp2f(p1[i] - m_run); rs += p0[i] + p1[i]; }
            if (redo || !__any(!(rs < 1e18f))) break;
            redo = true;
        }
        l_run += rs;
#undef ATT_QK
#undef ATT_ROWMAX
#pragma unroll
        for (int s = 0; s < 2; ++s) {
            u32x4 w0, w1;
            w0.x = cvtpk(p0[8 * s + 0], p0[8 * s + 1]); w0.y = cvtpk(p0[8 * s + 2], p0[8 * s + 3]); w0.z = cvtpk(p0[8 * s + 4], p0[8 * s + 5]); w0.w = cvtpk(p0[8 * s + 6], p0[8 * s + 7]);
            w1.x = cvtpk(p1[8 * s + 0], p1[8 * s + 1]); w1.y = cvtpk(p1[8 * s + 2], p1[8 * s + 3]); w1.z = cvtpk(p1[8 * s + 4], p1[8 * s + 5]); w1.w = cvtpk(p1[8 * s + 6], p1[8 * s + 7]);
            pb[s] = __builtin_bit_cast(bf16x8, w0); pb[2 + s] = __builtin_bit_cast(bf16x8, w1);
        }
        pv_tile(o, lds + vcur + voff, pb);
        __builtin_amdgcn_iglp_opt(0);
        if (t + 1 < nt) {
#pragma unroll
            for (int i = 0; i < 2; ++i) { *(LAS u32x4*)(lds + knxt + kdst[i]) = kr[i]; *(LAS u32x2*)(lds + vnxt + vdst[i]) = (u32x2){vr[i].x, vr[i].y}; *(LAS u32x2*)(lds + vnxt + vdst[i] + 16) = (u32x2){vr[i].z, vr[i].w}; }
        }
        vprev = vcur; vcur = vnxt;
        __syncthreads();
    }
    __syncthreads();
    const float inv = 1.0f / half_sum(l_run);
    LAS float* ox = (LAS float*)(lds + OX_OFF) + rg * 4096 + lane;
    if (mp == 1) {
        const float f = inv * lam;
#pragma unroll
        for (int d = 0; d < 4; ++d)
#pragma unroll
            for (int i = 0; i < 16; ++i) ox[(d * 16 + i) * 64] = o[d][i] * f;
    }
    __syncthreads();
    if (mp == 0) {
        float ss = 0.f;
#pragma unroll
        for (int d = 0; d < 4; ++d)
#pragma unroll
            for (int i = 0; i < 16; ++i) { const float a = o[d][i] * inv - ox[(d * 16 + i) * 64]; o[d][i] = a; ss += a * a; }
        ss = half_sum(ss);
        const float rn = (1.0f / sqrtf(ss * (1.0f / 128.0f) + EPS)) * 0.8f;
        bf16* orow = Op + (size_t)(rg * 32 + r) * DM;
#pragma unroll
        for (int d = 0; d < 4; ++d)
#pragma unroll
            for (int g = 0; g < 4; ++g) { const int d0 = 32 * d + 8 * g + 4 * hi; const f32x4 gv = *(const f32x4*)(subg + d0);
                const f32x4 y = {o[d][4 * g] * rn * gv[0], o[d][4 * g + 1] * rn * gv[1], o[d][4 * g + 2] * rn * gv[2], o[d][4 * g + 3] * rn * gv[3]};
                *(u32x2*)(orow + d0) = pack4(y); }
    }
    __syncthreads();
}
}

constexpr int ARGS_OFF = 147200;
__device__ __forceinline__ void* ldarg(LAS unsigned char* lds, int i) {
    const unsigned long long v = ((const LAS unsigned long long*)(lds + ARGS_OFF))[i];
    const unsigned lo = __builtin_amdgcn_readfirstlane((unsigned)v), hi = __builtin_amdgcn_readfirstlane((unsigned)(v >> 32));
    return (void*)(__attribute__((address_space(1))) void*)(((unsigned long long)hi << 32) | lo);
}
#define LDARG(i) ldarg(lds, (i))
#define x_prompt ((const float*)LDARG(0))
#define x_sample ((const float*)LDARG(1))
#define cin ((const float*)LDARG(2))
#define cache_k ((const float*)LDARG(3))
#define cache_v ((const float*)LDARG(4))
#define c_ctx ((const float*)LDARG(5))
#define w_ada ((const float*)LDARG(6))
#define b_ada ((const float*)LDARG(7))
#define norm1_g ((const float*)LDARG(8))
#define w_in ((const float*)LDARG(9))
#define lam_q1 ((const float*)LDARG(10))
#define lam_k1 ((const float*)LDARG(11))
#define lam_q2 ((const float*)LDARG(12))
#define lam_k2 ((const float*)LDARG(13))
#define subln_g ((const float*)LDARG(14))
#define w_pool ((const float*)LDARG(15))
#define pool_scale ((const float*)LDARG(16))
#define w_out ((const float*)LDARG(17))
#define norm2_g ((const float*)LDARG(18))
#define w_up ((const float*)LDARG(19))
#define conv_k ((const float*)LDARG(20))
#define conv_b ((const float*)LDARG(21))
#define w_down ((const float*)LDARG(22))
#define norm_f_g ((const float*)LDARG(23))
#define out ((float*)LDARG(24))
#define ws ((unsigned char*)LDARG(25))
#define state_k (out + (size_t)MROWS * DM)
#define state_v (out + (size_t)MROWS * DM + (size_t)NCTX * DATT)
#define ctl ((unsigned*)(ws + WS_CTL))
#define mod ((float*)(ws + WS_MOD))
#define rope ((float*)(ws + WS_ROPE))
#define WinT ((bf16*)(ws + WS_WIN))
#define WoutT ((bf16*)(ws + WS_WOUT))
#define WupT ((bf16*)(ws + WS_WUP))
#define WdownT ((bf16*)(ws + WS_WDOWN))
#define WpoolT ((bf16*)(ws + WS_WPOOL))
#define Hb ((bf16*)(ws + WS_H))
#define Qb ((bf16*)(ws + WS_Q))
#define Kc ((bf16*)(ws + WS_KC))
#define Kl ((bf16*)(ws + WS_KL))
#define Vtc ((bf16*)(ws + WS_VTC))
#define Vtl ((bf16*)(ws + WS_VTL))
#define Pb ((bf16*)(ws + WS_P))
#define Pooled ((bf16*)(ws + WS_POOLED))
#define AM ((bf16*)(ws + WS_AM))
#define ACT ((bf16*)(ws + WS_ACT))
#define ebuf ((float*)(ws + WS_EBUF))
#define RLX_AGENT __ATOMIC_RELAXED, __HIP_MEMORY_SCOPE_AGENT
#define XB_TMO      128
#define XB_XCNT(j)  (256  + 64 * (j))
#define XB_XSUB(j)  (1280 + 64 * (j))
#define XB_XGEN(j)  (2304 + 64 * (j))
#define XB_TOP      3328
#define XB_TOPGEN   3392
#define XCD_BAR_WORDS 3456
#define XB_SPIN_CAP (1u << 18)

__device__ __forceinline__ unsigned xb_ld(unsigned* p)              { return __hip_atomic_load(p, __ATOMIC_RELAXED, __HIP_MEMORY_SCOPE_AGENT); }
__device__ __forceinline__ unsigned xb_add(unsigned* p, unsigned v) { return __hip_atomic_fetch_add(p, v, __ATOMIC_RELAXED, __HIP_MEMORY_SCOPE_AGENT); }
__device__ __forceinline__ unsigned xb_xcc_id() { return (unsigned)__builtin_amdgcn_s_getreg((3 << 11) | 20) & 0xFu; }
#define XB_SPIN(cond, bar) do { unsigned _sp = 0; while (cond) { __builtin_amdgcn_s_sleep(1); \
    if ((++_sp & 255u) == 0u) { if (xb_ld(&(bar)[XB_TMO])) break; if (_sp > XB_SPIN_CAP) { atomicAdd(&(bar)[XB_TMO], 1u); break; } } } } while (0)

struct XcdBarrier {
    unsigned* bar; unsigned x;
    volatile LAS unsigned* st;
};

__device__ __forceinline__ XcdBarrier xcd_barrier_post(unsigned* bar, volatile LAS unsigned* st) {
    XcdBarrier b; b.bar = bar; b.x = xb_xcc_id(); b.st = st;
    if (threadIdx.x == 0) (void)xb_add(&bar[XB_XCNT(b.x)], 1u);
    return b;
}
__device__ __forceinline__ void xcd_barrier_complete(unsigned* bar, unsigned x, unsigned& nloc, unsigned& nx) {
    const unsigned G = gridDim.x * gridDim.y * gridDim.z;
    unsigned sum, cnt, mine, sp = 0u;
    for (;;) {
        sum = 0u; cnt = 0u; mine = 0u;
#pragma unroll
        for (unsigned j = 0; j < 16; ++j) { const unsigned c = xb_ld(&bar[XB_XCNT(j)]); sum += c; cnt += (c > 0u) ? 1u : 0u; mine = (j == x) ? c : mine; }
        if (sum == G) break;
        __builtin_amdgcn_s_sleep(1);
        if ((++sp & 255u) == 0u) { if (xb_ld(&bar[XB_TMO])) break; if (sp > XB_SPIN_CAP) { atomicAdd(&bar[XB_TMO], 1u); break; } }
    }
    nloc = mine > 0u ? mine : 1u; nx = cnt > 0u ? cnt : 1u;
}

__device__ __forceinline__ void xcd_barrier(const XcdBarrier& b) {
    asm volatile("s_waitcnt vmcnt(0)" ::: "memory");
    __syncthreads();
    if (threadIdx.x == 0) {
        unsigned* bar = b.bar;
        __builtin_amdgcn_s_waitcnt(0);
        unsigned nloc = b.st[0], nx = b.st[1];
        if (nloc == 0u) { xcd_barrier_complete(bar, b.x, nloc, nx); b.st[0] = nloc; b.st[1] = nx; }
        const unsigned old = xb_add(&bar[XB_XSUB(b.x)], 1u);
        const unsigned gen = old / nloc;
        if (old + 1u == (gen + 1u) * nloc) {
            __builtin_amdgcn_fence(__ATOMIC_RELEASE, "agent");
            asm volatile("s_waitcnt vmcnt(0)" ::: "memory");
            const unsigned og = xb_add(&bar[XB_TOP], 1u);
            const unsigned tg = og / nx;
            if (og + 1u == (tg + 1u) * nx) xb_add(&bar[XB_TOPGEN], 1u);
            else XB_SPIN(xb_ld(&bar[XB_TOPGEN]) == tg, bar);
            __builtin_amdgcn_fence(__ATOMIC_ACQUIRE, "agent");
            xb_add(&bar[XB_XGEN(b.x)], 1u);
            asm volatile("s_waitcnt vmcnt(0)" ::: "memory");
        } else {
            XB_SPIN(xb_ld(&bar[XB_XGEN(b.x)]) == gen, bar);
            __builtin_amdgcn_fence(__ATOMIC_ACQUIRE, "agent");
            asm volatile("s_waitcnt vmcnt(0)" ::: "memory");
        }
    }
    __syncthreads();
}

constexpr int CW_BAR = 1024, MISC_OFF = 147416;
struct MidBar { LAS unsigned char* lds; int at;
    __device__ __forceinline__ void operator()(int ui) const { if (ui == at) { XcdBarrier b_; b_.bar = (unsigned*)((unsigned char*)ldarg(lds, 25) + WS_CTL) + CW_BAR; b_.x = xb_xcc_id(); b_.st = (volatile LAS unsigned*)(lds + MISC_OFF); xcd_barrier(b_); } } };
__global__ void __launch_bounds__(512, 2) fwd_kernel(Args args) {
    extern __shared__ __attribute__((aligned(16))) unsigned char lds_raw[];
    LAS unsigned char* lds = (LAS unsigned char*)lds_raw;
    cg::grid_group grid = cg::this_grid();
    const int tid = threadIdx.x, lane = tid & 63, wave = __builtin_amdgcn_readfirstlane(tid >> 6);
    const int G = gridDim.x, bx = blockIdx.x;
    const int vcu = (G % 8 == 0) ? (bx % 8) * (G / 8) + bx / 8 : bx;
    const int gw = vcu * 8 + wave, NGW = G * 8;
    const int gt = bx * 512 + tid, GT = G * 512;
    if (tid == 0) { LAS unsigned long long* ap = (LAS unsigned long long*)(lds + ARGS_OFF);
        ap[0] = (unsigned long long)args.in[0];
        ap[1] = (unsigned long long)args.in[1];
        ap[2] = (unsigned long long)args.in[2];
        ap[3] = (unsigned long long)args.in[3];
        ap[4] = (unsigned long long)args.in[4];
        ap[5] = (unsigned long long)args.in[5];
        ap[6] = (unsigned long long)args.in[6];
        ap[7] = (unsigned long long)args.in[7];
        ap[8] = (unsigned long long)args.in[8];
        ap[9] = (unsigned long long)args.in[9];
        ap[10] = (unsigned long long)args.in[10];
        ap[11] = (unsigned long long)args.in[11];
        ap[12] = (unsigned long long)args.in[12];
        ap[13] = (unsigned long long)args.in[13];
        ap[14] = (unsigned long long)args.in[14];
        ap[15] = (unsigned long long)args.in[15];
        ap[16] = (unsigned long long)args.in[16];
        ap[17] = (unsigned long long)args.in[17];
        ap[18] = (unsigned long long)args.in[18];
        ap[19] = (unsigned long long)args.in[19];
        ap[20] = (unsigned long long)args.in[20];
        ap[21] = (unsigned long long)args.in[21];
        ap[22] = (unsigned long long)args.in[22];
        ap[23] = (unsigned long long)args.in[23];
        ap[24] = (unsigned long long)args.outp; ap[25] = (unsigned long long)args.wsp;
        ((LAS unsigned*)(lds + MISC_OFF))[0] = 0u; ((LAS unsigned*)(lds + MISC_OFF))[1] = 0u; }
    __syncthreads();
    { XcdBarrier b0_ = xcd_barrier_post(ctl + CW_BAR, (volatile LAS unsigned*)(lds + MISC_OFF)); (void)b0_; }
#define GRID_BAR() do { XcdBarrier b_; b_.bar = ctl + CW_BAR; b_.x = xb_xcc_id(); b_.st = (volatile LAS unsigned*)(lds + MISC_OFF); xcd_barrier(b_); } while (0)

#if PH0
    if (bx == G - 1) {
        for (int e = tid; e < 1024; e += 512) { const int pos = e >> 4, f = e & 15; const float inv = exp2f(-(float)f * (13.287712379549449f / 16.0f)); const float a = (float)pos * inv; float sn, cs; sincosf(a, &sn, &cs); rope[2 * e] = cs; rope[2 * e + 1] = sn; }
    }
    for (int j = bx; j < 128; j += G) {
        LAS float* scond = (LAS float*)lds; LAS float* red = (LAS float*)(lds + 73728);
        for (int e = tid; e < 9 * DM; e += 512) { const int b = e >> 11, k = e & 2047; const float v = (b < 8) ? cin[b * DM + k] : c_ctx[k]; scond[e] = v / (1.0f + expf(-v)); }
        __syncthreads();
        const int cgp = tid % 24, kl = tid / 24;
        f32x4 acc[9];
#pragma unroll
        for (int b = 0; b < 9; ++b) acc[b] = (f32x4){0.f, 0.f, 0.f, 0.f};
        if (kl < 21) {
            const float* wp = w_ada + 96 * j + 4 * cgp;
#pragma unroll 4
            for (int k = kl; k < DM; k += 21) { const f32x4 w = *(const f32x4*)(wp + (size_t)k * NMOD);
#pragma unroll
                for (int b = 0; b < 9; ++b) acc[b] += w * scond[b * DM + k]; }
#pragma unroll
            for (int b = 0; b < 9; ++b) *(LAS f32x4*)(red + (kl * 9 + b) * 96 + 4 * cgp) = acc[b];
        }
        __syncthreads();
        for (int e = tid; e < 9 * 96; e += 512) { const int b = e / 96, c = e % 96; float s = b_ada[96 * j + c];
            for (int q = 0; q < 21; ++q) s += red[(q * 9 + b) * 96 + c];
            mod[b * NMOD + 96 * j + c] = s; }
        __syncthreads();
    }
    {
        LAS float* scr = (LAS float*)(lds + wave * 8448);
        for (;;) {
            int it = 0; if (lane == 0) it = (int)atomicAdd(ctl, 1u); it = __builtin_amdgcn_readfirstlane(it);
            if (it >= (G == 256 ? IT_TOTAL - IT_WDOWN : IT_TOTAL)) break;
            int r_ = it;
            if (r_ < IT_WIN) { const int nb = DIN / 32; transpose_item(w_in, DIN, 64 * (r_ / nb), 32 * (r_ % nb), WinT, DM, 32 * (r_ % nb), scr, lane); continue; } r_ -= IT_WIN;
            if (r_ < IT_WOUT) { const int nb = DM / 32; transpose_item(w_out, DM, 64 * (r_ / nb), 32 * (r_ % nb), WoutT, DM, 32 * (r_ % nb), scr, lane); continue; } r_ -= IT_WOUT;
            if (r_ < IT_WUP) { const int nb = NUP / 32; const int n0 = 32 * (r_ % nb); const int drow = n0 < DFF ? (n0 / 128) * 256 + (n0 % 128) : ((n0 - DFF) / 128) * 256 + 128 + ((n0 - DFF) % 128);
                transpose_item(w_up, NUP, 64 * (r_ / nb), n0, WupT, DM, drow, scr, lane); continue; } r_ -= IT_WUP;
            if (r_ < IT_WPOOL) { const int g = r_ >> 5, q = r_ & 31; transpose_item(w_pool + (size_t)g * 65536, 256, 64 * (q >> 3), 32 * (q & 7), WpoolT + (size_t)g * 65536, 256, 32 * (q & 7), scr, lane); continue; } r_ -= IT_WPOOL;
            if (r_ < IT_CV) { const int b = r_ >> 8, q = r_ & 255;
                transpose_item(cache_v + (size_t)b * PAST * DATT, DATT, 64 * (q >> 5), 32 * (q & 31), Vtl + (size_t)b * DATT * TALL, TALL, 32 * (q & 31), scr, lane); continue; } r_ -= IT_CV;
            if (r_ >= IT_CK) { r_ -= IT_CK; const int nb = DM / 32; transpose_item(w_down, DM, 64 * (r_ / nb), 32 * (r_ % nb), WdownT, DFF, 32 * (r_ % nb), scr, lane); continue; }
            { const int b = r_ >> 9, key = r_ & 511; const f32x4* src = (const f32x4*)(cache_k + ((size_t)b * PAST + key) * DATT); bf16* dst = Kl + ((size_t)b * TALL + key) * DATT;
#pragma unroll
              for (int j = 0; j < 4; ++j) *(u32x2*)(dst + 4 * lane + 256 * j) = pack4(src[lane + 64 * j]); }
        }
    }
#endif
    grid.sync();
#if PH1
    for (int row = gw; row < MROWS; row += NGW) {
        const float* xr = row < NCTX ? x_prompt + (size_t)row * DM : x_sample + (size_t)(row - NCTX) * DM; const int bidx = row < NCTX ? 8 : (row - NCTX) >> 11;
        norm_row(xr, norm1_g, mod + (size_t)bidx * NMOD + DM, mod + (size_t)bidx * NMOD, Hb + (size_t)row * DM, nullptr, lane);
    }
#endif
    GRID_BAR();
#if PH2
    {
        pg8::Gemm g{Hb, WinT, DM, DM, DM, 0}; pg8::StaticOrder S; S.init(MROWS, DIN, G, bx);
        pg8::EpiInProj E{Qb, Kc, Kl, Vtc, Vtl, Pb, state_k, state_v, rope};
        pg8::gemm_phase<pg8::EpiInProj, pg8::StaticOrder, true, true>(lds, g, S, E);
    }
#endif
    GRID_BAR();
#if PH3
    for (int item = gt; item < (MROWS / 8) * 128; item += GT) {
        const int g = (item >> 6) & 3, rb8 = (item >> 8) * 2 + ((item >> 5) & 1), c8 = g * 32 + (item & 31);
        const int row0 = rb8 * 8;
        const int T = row0 < NCTX ? TCTX : TLAT, t0 = row0 < NCTX ? (row0 & (TCTX - 1)) : ((row0 - NCTX) & (TLAT - 1));
        const bf16* base = Pb + (size_t)(row0 - t0) * DATT + c8 * 8; bf16* obase = Pooled + (size_t)(row0 - t0) * DATT + c8 * 8;
        if (g == 0) pool_item<1>(base, obase, t0, T); else if (g == 1) pool_item<2>(base, obase, t0, T); else if (g == 2) pool_item<4>(base, obase, t0, T); else pool_item<8>(base, obase, t0, T);
    }
    {
        const float s1 = wave_sum(lam_q1[lane] * lam_k1[lane]), s2 = wave_sum(lam_q2[lane] * lam_k2[lane]);
        const float lam = expf(s1) - expf(s2) + 0.2f;
        const int per = (1024 + G - 1) / G;
        for (int i = 0; i < per; ++i) { const int idx = vcu * per + i; if (idx >= 1024) break;
            const int b = idx >> 7, h = (idx >> 4) & 7, qb = idx & 15; const size_t qrow0 = (size_t)NCTX + (size_t)b * TLAT + qb * 128;
            att::unit(lds, Qb + qrow0 * DATT + h * 128, Kl + (size_t)b * TALL * DATT + h * 128, Vtl + (size_t)(b * 8 + h) * 128 * TALL, TALL, TALL / 64, AM + qrow0 * DM + h * 128, lam, subln_g); }
        for (int idx = vcu; idx < 256; idx += G) {
            const int b = idx >> 4, h = (idx >> 1) & 7, qb = idx & 1; const size_t qrow0 = (size_t)b * TCTX + qb * 128;
            att::unit(lds, Qb + qrow0 * DATT + h * 128, Kc + (size_t)b * TCTX * DATT + h * 128, Vtc + (size_t)(b * 8 + h) * 128 * TCTX, TCTX, TCTX / 64, AM + qrow0 * DM + h * 128, lam, subln_g); }
    }
#endif
    GRID_BAR();
#if PH3B
    {
        int kp = 256; asm volatile("" : "+s"(kp));
        pg8::Gemm g{Pooled, WpoolT, DATT, 256, kp, 256}; pg8::StaticOrder S; S.init(MROWS, DATT, G, bx);
        pg8::EpiPool E{AM, pool_scale};
        pg8::gemm_phase<pg8::EpiPool, pg8::StaticOrder, true, true>(lds, g, S, E);
    }
#endif
    GRID_BAR();
#if PH4
    {
        pg8::Gemm g{AM, WoutT, DM, DM, DM, 0}; pg8::PanelOrder S; S.init(MROWS, DM, G, bx);
        pg8::EpiGateBf16 E{Hb, mod + 2 * DM};
        MidBar MB{lds, S.fast ? 1 : -1};
        pg8::gemm_phase<pg8::EpiGateBf16, pg8::PanelOrder, true, true, MidBar>(lds, g, S, E, MB);
#define P5_ROW(row) { const int bidx = (row) < NCTX ? 8 : ((row) - NCTX) >> 11; const float* xr = (row) < NCTX ? x_prompt + (size_t)(row) * DM : x_sample + (size_t)((row) - NCTX) * DM; \
        norm_row(xr, norm2_g, mod + (size_t)bidx * NMOD + 4 * DM, mod + (size_t)bidx * NMOD + 3 * DM, AM + (size_t)(row) * DM, nullptr, lane, Hb + (size_t)(row) * DM, nullptr); }
        if (S.fast && bx >= 128) {
            for (int row = (bx - 128) * 8 + wave; row < 64 * 256; row += 1024) P5_ROW(row)
        }
    }
#endif
    GRID_BAR();
#if PH5
    for (int row = (G == 256 ? 64 * 256 : 0) + gw; row < MROWS; row += NGW) P5_ROW(row)
#undef P5_ROW
#endif
    GRID_BAR();
#if PH6
    {
        pg8::Gemm g{AM, WupT, DM, DM, DM, 0}; pg8::StaticOrder S; S.init(MROWS, NUP, G, bx);
        pg8::EpiUp E{ACT, ebuf, conv_k, conv_b, (LAS float*)(lds + XL_OFF)};
        pg8::gemm_phase<pg8::EpiUp, pg8::StaticOrder, true, true>(lds, g, S, E);
        if (gridDim.x == 256 && blockIdx.x >= 112) {
            int t_ = threadIdx.x; asm volatile("" : "+v"(t_));
            const int ln_ = t_ & 63, wv_ = __builtin_amdgcn_readfirstlane(t_ >> 6);
            LAS float* scr = (LAS float*)(lds + wv_ * 8448);
            for (int it = ((int)blockIdx.x - 112) * 8 + wv_; it < IT_WDOWN; it += 144 * 8) transpose_item(w_down, DM, 64 * (it >> 6), 32 * (it & 63), WdownT, DFF, 32 * (it & 63), scr, ln_);
        }
    }
#endif
    GRID_BAR();
#if PH7
    for (int item = gt; item < 56 * DFF; item += GT) {
        const int bnd = item / DFF, j = item % DFF; const int pmA = 16 + (bnd / 7) * 8 + (bnd % 7), pmB = pmA + 1;
        const int tcg = (j >> 7) * 256 + (j & 127), tcv = tcg + 128;
        const float* eA = ebuf + (size_t)pmA * 4 * NUP; const float* eB = ebuf + (size_t)pmB * 4 * NUP;
        const float g254 = eA[2 * NUP + tcg], g255 = eA[3 * NUP + tcg], g0 = eB[tcg], g1 = eB[NUP + tcg];
        const float v254 = eA[2 * NUP + tcv], v255 = eA[3 * NUP + tcv], v0 = eB[tcv], v1 = eB[NUP + tcv];
        const float k0g = conv_k[j], k1g = conv_k[NUP + j], k2g = conv_k[2 * NUP + j], bg = conv_b[j];
        const float k0v = conv_k[DFF + j], k1v = conv_k[NUP + DFF + j], k2v = conv_k[2 * NUP + DFF + j], bv = conv_b[DFF + j];
        const float ga = k0g * g254 + k1g * g255 + k2g * g0 + bg, va = k0v * v254 + k1v * v255 + k2v * v0 + bv;
        const float gb = k0g * g255 + k1g * g0 + k2g * g1 + bg, vb = k0v * v255 + k1v * v0 + k2v * v1 + bv;
        ACT[((size_t)pmA * 256 + 255) * DFF + j] = pg8::bf1(ga / (1.0f + __expf(-ga)) * va);
        ACT[((size_t)pmB * 256) * DFF + j] = pg8::bf1(gb / (1.0f + __expf(-gb)) * vb);
    }
#endif
    GRID_BAR();
#if PH8
    {
        pg8::Gemm g{ACT, WdownT, DFF, DFF, DFF, 0}; pg8::PanelOrder S; S.init(MROWS, DM, G, bx);
        pg8::EpiGateBf16 E{AM, mod + 5 * DM};
        MidBar MB{lds, S.fast ? 1 : -1};
        pg8::gemm_phase<pg8::EpiGateBf16, pg8::PanelOrder, true, true, MidBar>(lds, g, S, E, MB);
#define P9_ROW(row) { const float* xr = (row) < NCTX ? x_prompt + (size_t)(row) * DM : x_sample + (size_t)((row) - NCTX) * DM; \
        norm_row(xr, norm_f_g, nullptr, nullptr, nullptr, out + (size_t)(row) * DM, lane, Hb + (size_t)(row) * DM, AM + (size_t)(row) * DM); }
        if (S.fast && bx >= 128) {
            for (int row = (bx - 128) * 8 + wave; row < 64 * 256; row += 1024) P9_ROW(row)
        }
    }
#endif
    GRID_BAR();
#if PH9
    for (int row = (G == 256 ? 64 * 256 : 0) + gw; row < MROWS; row += NGW) P9_ROW(row)
#undef P9_ROW
#endif

}

#undef x_prompt
#undef x_sample
#undef cin
#undef cache_k
#undef cache_v
#undef c_ctx
#undef w_ada
#undef b_ada
#undef norm1_g
#undef w_in
#undef lam_q1
#undef lam_k1
#undef lam_q2
#undef lam_k2
#undef subln_g
#undef w_pool
#undef pool_scale
#undef w_out
#undef norm2_g
#undef w_up
#undef conv_k
#undef conv_b
#undef w_down
#undef norm_f_g
#undef out
#undef ws
#undef state_k
#undef state_v
#undef ctl
#undef mod
#undef rope
#undef WinT
#undef WoutT
#undef WupT
#undef WdownT
#undef WpoolT
#undef Hb
#undef Qb
#undef Kc
#undef Kl
#undef Vtc
#undef Vtl
#undef Pb
#undef Pooled
#undef AM
#undef ACT
#undef ebuf
extern "C" void kernel_launch(void* const* d_in, const int* in_sizes, int n_in, void* d_out, int out_size, void* d_ws, size_t ws_size, hipStream_t stream) {
    static int grid = 0;
    if (grid == 0) {
        if (n_in != 24 || ws_size < WS_END) { fprintf(stderr, "kernel_launch: unexpected n_in %d / ws_size %zu\n", n_in, ws_size); grid = -1; return; }
        int dev = 0, cus = 0, per_cu = 0;
        (void)hipGetDevice(&dev); (void)hipDeviceGetAttribute(&cus, hipDeviceAttributeMultiprocessorCount, dev);
        (void)hipFuncSetAttribute((const void*)fwd_kernel, hipFuncAttributeMaxDynamicSharedMemorySize, LDS_BYTES);
        (void)hipOccupancyMaxActiveBlocksPerMultiprocessor(&per_cu, (const void*)fwd_kernel, 512, LDS_BYTES);
        if (per_cu < 1) { fprintf(stderr, "kernel_launch: occupancy query returned %d\n", per_cu); per_cu = 1; }
        (void)hipGetLastError();
        grid = cus * 1;
    }
    if (grid < 0) return;
    (void)hipMemsetAsync((char*)d_ws + WS_CTL, 0, CTL_ZERO_BYTES, stream);
    Args a{};
    for (int i = 0; i < 24; ++i) a.in[i] = (const float*)d_in[i];
    a.outp = (float*)d_out; a.wsp = (unsigned char*)d_ws;
    void* kargs[] = {&a};
    hipError_t e = hipLaunchCooperativeKernel((const void*)fwd_kernel, dim3(grid), dim3(512), kargs, LDS_BYTES, stream);
    if (e != hipSuccess) fprintf(stderr, "kernel_launch: cooperative launch failed: %s (grid %d)\n", hipGetErrorString(e), grid);
}
```

```cpp
#include <hip/hip_runtime.h>
#include <hip/hip_cooperative_groups.h>
#include <cstdio>
#include <cstdint>
namespace cg = cooperative_groups;
#ifndef PH0
#define PH0 1
#endif
#ifndef PH1
#define PH1 1
#endif
#ifndef PH2
#define PH2 1
#endif
#ifndef PH3
#define PH3 1
#endif
#ifndef PH3B
#define PH3B 1
#endif
#ifndef PH4
#define PH4 1
#endif
#ifndef PH5
#define PH5 1
#endif
#ifndef PH6
#define PH6 1
#endif
#ifndef PH7
#define PH7 1
#endif
#ifndef PH8
#define PH8 1
#endif
#ifndef PH9
#define PH9 1
#endif

constexpr int DM = 2048, NCTX = 4096, NLAT = 16384, MROWS = 20480, DIN = 4096, DFF = 5504, NUP = 11008, DATT = 1024;
constexpr int TCTX = 256, TLAT = 2048, PAST = 512, TALL = 2560, NMOD = 12288;
constexpr float EPS = 1e-6f;
constexpr float QSCALE = 0.125f * 1.4426950408889634f;
namespace pg8 {
#define PG8_LAS __attribute__((address_space(3)))
typedef unsigned short bf16_t;
typedef short bf16x8 __attribute__((ext_vector_type(8)));
typedef float f32x4 __attribute__((ext_vector_type(4)));
typedef unsigned u32x4 __attribute__((ext_vector_type(4)));
constexpr int BM = 256, BK = 64, HALF = 128, HTB = HALF * BK * 2  , STAGE_BYTES = 8 * HTB, NXCD = 8, WGM = 4;

__host__ __device__ __forceinline__ int lds_byte(int r, int c) { const int st = (r >> 4) * 2 + (c >> 5), rr = r & 15, cc = c & 31, ob = rr * 64 + cc * 2; return st * 1024 + (ob ^ (((ob >> 9) & 1) << 5)); }
__host__ __device__ __forceinline__ void stage_rc(int b, int& R, int& C) { const int st = b / 1024, sb = b % 1024, swz = sb ^ (((sb >> 9) & 1) << 5); R = (st >> 1) * 16 + swz / 64; C = (st & 1) * 32 + (swz % 64) / 2; }
__host__ __device__ __forceinline__ int perm32(int rho) { const int n = rho >> 4, i = rho & 15; return 8 * (i >> 2) + 4 * n + (i & 3); }

struct Unit { int pm, pn; };
struct Gemm { const bf16_t* A; const bf16_t* Bt; int lda, ldb, K, acol; };

struct StaticOrder {
    int nM, nN, nwg, G, c;
    __host__ __device__ void init(int M, int N, int G_, int c_) { nM = M / BM; nN = N / BM; nwg = nM * nN; G = G_; c = c_; }
    __host__ __device__ bool next(int i, Unit& u) const {
        const long L = (long)i * G + c; if (L >= nwg) return false;
        int wgid = (int)L; { const int q = nwg / NXCD, r = nwg % NXCD, xcd = wgid % NXCD, off = wgid / NXCD; wgid = (xcd < r ? xcd * (q + 1) : r * (q + 1) + (xcd - r) * q) + off; }
        const int nig = WGM * nN, gid = wgid / nig, fm = gid * WGM, gsz = (nM - fm) < WGM ? (nM - fm) : WGM;
        u.pm = fm + ((wgid % nig) % gsz); u.pn = (wgid % nig) / gsz; return true;
    }
    __device__ __forceinline__ void a_ready(const Unit&) const {}
    __device__ __forceinline__ void done(const Unit&) const {}
};

struct PanelOrder {
    StaticOrder so; bool fast;
    __host__ __device__ void init(int M, int N, int G_, int c_) { so.init(M, N, G_, c_); fast = (G_ == 256 && so.nN == 8 && so.nM == 80); }
    __host__ __device__ bool next(int i, Unit& u) const {
        if (!fast) return so.next(i, u);
        const int c = so.c, xcd = c & 7, j = c >> 3;
        if (i < 2) { u.pm = i * 32 + xcd * 4 + (j & 3); u.pn = j >> 2; return true; }
        if (i == 2 && c < 128) { u.pm = 64 + xcd * 2 + (j & 1); u.pn = j >> 1; return true; }
        return false;
    }
    __device__ __forceinline__ void a_ready(const Unit&) const {}
    __device__ __forceinline__ void done(const Unit&) const {}
};

struct NoMid { __device__ __forceinline__ void operator()(int) const {} };
template <class Epi, class Sched, bool ALIGN_EPI = false, bool SP2 = false, class Mid = NoMid>
__device__ __forceinline__ void gemm_phase(PG8_LAS unsigned char* lds, const Gemm g, const Sched& S, const Epi& E, const Mid& MH = Mid()) {
    int tid_ = threadIdx.x; asm volatile("" : "+v"(tid_));
    const int tid = tid_, wid = __builtin_amdgcn_readfirstlane(tid >> 6), lane = tid & 63, wr = wid >> 2, wc = wid & 3, fr = lane & 15, fq = lane >> 4;
    const int K = g.K, nt = K / BK;
    unsigned voffA[2], voffB[2];
#pragma unroll
    for (int i = 0; i < 2; ++i) { int R, C; stage_rc(tid * 16 + i * 8192, R, C); const int Rb = Epi::PERM ? ((R & ~31) + perm32(R & 31)) : R;
        voffA[i] = (unsigned)(R * g.lda + C) * 2u; voffB[i] = (unsigned)(Rb * g.ldb + C) * 2u; }
    const size_t kstep = (size_t)(BK * 2);
    const size_t hstepA = (size_t)HALF * g.lda * 2, hstepB = (size_t)HALF * g.ldb * 2;
    const size_t tstepA = 2 * hstepA, tstepB = 2 * hstepB, acolb = (size_t)g.acol * 2;
    const unsigned ldsw = (unsigned)wid * 1024u;
    const int aoff = lds_byte(wr * 64 + fr, fq * 8), boff = lds_byte(wc * 32 + fr, fq * 8);
#define PG8_SA(b, h) (((b) * 2 + (h)) * HTB)
#define PG8_SB(b, h) ((4 + (b) * 2 + (h)) * HTB)
#define PG8_STAGE(bufoff, gbase, voff) do { _Pragma("unroll") for (int _i = 0; _i < 2; ++_i) \
        __builtin_amdgcn_global_load_lds((const unsigned*)((const char*)(gbase) + (voff)[_i]), (PG8_LAS unsigned*)(lds + (bufoff) + ldsw + _i * 8192), 16, 0, 0); } while (0)
#define PG8_LDA(dst, b, h) do { _Pragma("unroll") for (int m = 0; m < 4; ++m) _Pragma("unroll") for (int k = 0; k < 2; ++k) dst[m][k] = *(const PG8_LAS bf16x8*)(lds + PG8_SA(b, h) + aoff + m * 2048 + k * 1024); } while (0)
#define PG8_LDB(dst, b, h) do { _Pragma("unroll") for (int n = 0; n < 2; ++n) _Pragma("unroll") for (int k = 0; k < 2; ++k) dst[n][k] = *(const PG8_LAS bf16x8*)(lds + PG8_SB(b, h) + boff + n * 2048 + k * 1024); } while (0)
#define PG8_MMA(ai, bj, At, Bt) do { __builtin_amdgcn_s_setprio(1); _Pragma("unroll") for (int m = 0; m < 4; ++m) _Pragma("unroll") for (int n = 0; n < 2; ++n) _Pragma("unroll") for (int k = 0; k < 2; ++k) \
        acc[ai][bj][m][n] = __builtin_amdgcn_mfma_f32_16x16x32_bf16(Bt[n][k], At[m][k], acc[ai][bj][m][n], 0, 0, 0); __builtin_amdgcn_s_setprio(0); } while (0)
#define PG8_WAIT_V(n) asm volatile("s_waitcnt vmcnt(" #n ")" ::: "memory")
#define PG8_WAIT_L(n) asm volatile("s_waitcnt lgkmcnt(" #n ")" ::: "memory")
#define PG8_BAR __builtin_amdgcn_s_barrier()
#define PG8_SCHED __builtin_amdgcn_sched_barrier(0)
    Unit cur, nxt; int ui = 0;
    if (!S.next(0, cur)) return;
    f32x4 acc[2][2][4][2];
#pragma unroll
    for (int a = 0; a < 2; ++a)
#pragma unroll
        for (int b = 0; b < 2; ++b)
#pragma unroll
            for (int m = 0; m < 4; ++m)
#pragma unroll
                for (int n = 0; n < 2; ++n) acc[a][b][m][n] = (f32x4){0.f, 0.f, 0.f, 0.f};
    bf16x8 At[4][2], B0[2][2], B1[2][2];
    const char* cA = (const char*)g.A + (size_t)cur.pm * tstepA + (size_t)cur.pn * acolb; const char* cB = (const char*)g.Bt + (size_t)cur.pn * tstepB;
    S.a_ready(cur);
    if constexpr (SP2) {
        PG8_STAGE(PG8_SB(0, 0), cB, voffB); PG8_STAGE(PG8_SB(0, 1), cB + hstepB, voffB); PG8_STAGE(PG8_SA(0, 0), cA, voffA); PG8_STAGE(PG8_SA(0, 1), cA + hstepA, voffA);
        if (wr == 1) PG8_BAR;
        PG8_WAIT_V(2); PG8_BAR;
        PG8_STAGE(PG8_SB(1, 0), cB + kstep, voffB); PG8_STAGE(PG8_SA(1, 0), cA + kstep, voffA); PG8_STAGE(PG8_SB(1, 1), cB + hstepB + kstep, voffB);
        PG8_WAIT_V(6); PG8_BAR;
    } else {
        PG8_STAGE(PG8_SB(0, 0), cB, voffB); PG8_STAGE(PG8_SA(0, 0), cA, voffA); PG8_STAGE(PG8_SB(0, 1), cB + hstepB, voffB); PG8_STAGE(PG8_SA(0, 1), cA + hstepA, voffA);
        if (wr == 1) PG8_BAR;
        PG8_WAIT_V(4); PG8_BAR;
        PG8_STAGE(PG8_SB(1, 0), cB + kstep, voffB); PG8_STAGE(PG8_SA(1, 0), cA + kstep, voffA); PG8_STAGE(PG8_SB(1, 1), cB + hstepB + kstep, voffB);
        PG8_WAIT_V(6); PG8_BAR;
    }
    for (;;) {
        const bool has_next = S.next(ui + 1, nxt);
        const char* nA = has_next ? (const char*)g.A + (size_t)nxt.pm * tstepA + (size_t)nxt.pn * acolb : cA; const char* nB = has_next ? (const char*)g.Bt + (size_t)nxt.pn * tstepB : cB;
        for (int t = 0; t < nt; t += 2) {
            const bool last = (t == nt - 2);
            const char* a1 = cA + (size_t)(t + 1) * kstep;
            const char* a2 = last ? nA : cA + (size_t)(t + 2) * kstep; const char* b2 = last ? nB : cB + (size_t)(t + 2) * kstep;
            const char* a3 = a2 + kstep; const char* b3 = b2 + kstep;
            if (last && has_next) S.a_ready(nxt);
            if constexpr (SP2) {
            PG8_LDB(B0, 0, 0); PG8_LDB(B1, 0, 1); PG8_SCHED; PG8_LDA(At, 0, 0); PG8_STAGE(PG8_SA(1, 1), a1 + hstepA, voffA);
            PG8_WAIT_V(8); PG8_WAIT_L(0); PG8_BAR; PG8_MMA(0, 0, At, B0); PG8_MMA(0, 1, At, B1); PG8_BAR; PG8_SCHED;
            PG8_LDA(At, 0, 1); PG8_STAGE(PG8_SB(0, 0), b2, voffB); PG8_STAGE(PG8_SB(0, 1), b2 + hstepB, voffB); PG8_STAGE(PG8_SA(0, 0), a2, voffA);
            PG8_WAIT_V(8); PG8_WAIT_L(0); PG8_BAR; PG8_MMA(1, 0, At, B0); PG8_MMA(1, 1, At, B1); PG8_BAR; PG8_SCHED;
            PG8_LDB(B0, 1, 0); PG8_LDB(B1, 1, 1); PG8_SCHED; PG8_LDA(At, 1, 0); PG8_STAGE(PG8_SA(0, 1), a2 + hstepA, voffA);
            PG8_WAIT_V(8); PG8_WAIT_L(0); PG8_BAR; PG8_MMA(0, 0, At, B0); PG8_MMA(0, 1, At, B1); PG8_BAR; PG8_SCHED;
            PG8_LDA(At, 1, 1); PG8_STAGE(PG8_SB(1, 0), b3, voffB); PG8_STAGE(PG8_SB(1, 1), b3 + hstepB, voffB); PG8_STAGE(PG8_SA(1, 0), a3, voffA);
            PG8_WAIT_V(8); PG8_WAIT_L(0); PG8_BAR; PG8_MMA(1, 0, At, B0); PG8_MMA(1, 1, At, B1); PG8_BAR; PG8_SCHED;
            } else {
            PG8_LDB(B0, 0, 0); PG8_SCHED; PG8_LDA(At, 0, 0); PG8_STAGE(PG8_SA(1, 1), a1 + hstepA, voffA);
            PG8_WAIT_L(8); PG8_BAR; PG8_WAIT_L(0); PG8_MMA(0, 0, At, B0); PG8_BAR; PG8_SCHED;
            PG8_LDB(B1, 0, 1); PG8_STAGE(PG8_SB(0, 0), b2, voffB);
            PG8_BAR; PG8_WAIT_L(0); PG8_MMA(0, 1, At, B1); PG8_BAR;
            PG8_LDA(At, 0, 1); PG8_STAGE(PG8_SA(0, 0), a2, voffA);
            PG8_BAR; PG8_WAIT_L(0); PG8_MMA(1, 0, At, B0); PG8_BAR; PG8_SCHED;
            PG8_STAGE(PG8_SB(0, 1), b2 + hstepB, voffB);
            PG8_WAIT_V(6); PG8_BAR; PG8_MMA(1, 1, At, B1); PG8_BAR;
            PG8_LDB(B0, 1, 0); PG8_SCHED; PG8_LDA(At, 1, 0); PG8_STAGE(PG8_SA(0, 1), a2 + hstepA, voffA);
            PG8_WAIT_L(8); PG8_BAR; PG8_WAIT_L(0); PG8_MMA(0, 0, At, B0); PG8_BAR; PG8_SCHED;
            PG8_LDB(B1, 1, 1); PG8_STAGE(PG8_SB(1, 0), b3, voffB);
            PG8_BAR; PG8_WAIT_L(0); PG8_MMA(0, 1, At, B1); PG8_BAR;
            PG8_LDA(At, 1, 1); PG8_STAGE(PG8_SA(1, 0), a3, voffA);
            PG8_BAR; PG8_WAIT_L(0); PG8_MMA(1, 0, At, B0); PG8_BAR; PG8_SCHED;
            PG8_STAGE(PG8_SB(1, 1), b3 + hstepB, voffB);
            PG8_WAIT_V(6); PG8_BAR; PG8_MMA(1, 1, At, B1); PG8_BAR;
            }
        }
        if constexpr (ALIGN_EPI) { if (wr == 0) PG8_BAR; }
        if constexpr (!Epi::AFTER_DRAIN) { E(acc, cur, wr, wc, fr, fq); S.done(cur); }
        MH(ui);
        if (!has_next) break;
#pragma unroll
        for (int a = 0; a < 2; ++a)
#pragma unroll
            for (int b = 0; b < 2; ++b)
#pragma unroll
                for (int m = 0; m < 4; ++m)
#pragma unroll
                    for (int n = 0; n < 2; ++n) acc[a][b][m][n] = (f32x4){0.f, 0.f, 0.f, 0.f};
        cur = nxt; cA = nA; cB = nB; ++ui;
        if constexpr (ALIGN_EPI) { if (wr == 1) PG8_BAR; }
    }
    PG8_WAIT_V(0);
    if constexpr (!ALIGN_EPI) { if (wr == 0) PG8_BAR; }
    PG8_BAR;
    if constexpr (Epi::AFTER_DRAIN) { E.fused(acc, cur, wr, wc, fr, fq, lds, wid, lane); S.done(cur); }
#undef PG8_SA
#undef PG8_SB
#undef PG8_STAGE
#undef PG8_LDA
#undef PG8_LDB
#undef PG8_MMA
#undef PG8_WAIT_V
#undef PG8_WAIT_L
#undef PG8_BAR
#undef PG8_SCHED
}
typedef float f32x2 __attribute__((ext_vector_type(2)));
typedef __bf16 bf16x2_t __attribute__((ext_vector_type(2)));
typedef unsigned u32x2 __attribute__((ext_vector_type(2)));
__device__ __forceinline__ unsigned cvtpk(float lo, float hi) { f32x2 v = {lo, hi}; bf16x2_t b = __builtin_convertvector(v, bf16x2_t); return __builtin_bit_cast(unsigned, b); }
__device__ __forceinline__ u32x2 pack4(f32x4 v) { u32x2 w; w.x = cvtpk(v[0], v[1]); w.y = cvtpk(v[2], v[3]); return w; }
__device__ __forceinline__ unsigned short bf1(float v) { return (unsigned short)(cvtpk(v, 0.f) & 0xffffu); }

struct EpiInProj {
    static constexpr bool PERM = false, AFTER_DRAIN = false;
    bf16_t *Q, *Kc, *Kl, *Vtc, *Vtl, *P; float *sk, *sv; const float* rope;
    __device__ __forceinline__ void operator()(const f32x4 (&acc)[2][2][4][2], const Unit& u, int wr, int wc, int fr, int fq) const {
        const int kind = u.pn >> 2; const bool lat = u.pm >= 16; const int pml = u.pm - 16;
        const int b = lat ? (pml >> 3) : u.pm; const int t0 = lat ? (pml & 7) * 256 : 0; const int cb = (u.pn & 3) * 256;
#pragma unroll
        for (int ai = 0; ai < 2; ++ai)
#pragma unroll
            for (int m = 0; m < 4; ++m) {
                const int tl = ai * HALF + wr * 64 + m * 16 + fr; const int t = t0 + tl; const size_t row = (size_t)u.pm * BM + tl;
                f32x4 c0v = {1.f, 1.f, 1.f, 1.f}, s0v = {0.f, 0.f, 0.f, 0.f};
                if (kind <= 1 && lat) { const int pos = (wc & 1) ? (t & 63) : (t >> 6); const f32x4* rp = (const f32x4*)(rope + (pos * 16 + fq * 4) * 2);
                    const f32x4 a = rp[0], bq = rp[1]; c0v = (f32x4){a[0], a[2], bq[0], bq[2]}; s0v = (f32x4){a[1], a[3], bq[1], bq[3]}; }
#pragma unroll
                for (int bj = 0; bj < 2; ++bj) {
                    f32x4 v0 = acc[ai][bj][m][0], v1 = acc[ai][bj][m][1];
                    const int c0 = cb + bj * HALF + wc * 32 + fq * 4;
                    if (kind <= 1 && lat) { const f32x4 r0 = v0 * c0v - v1 * s0v, r1 = v1 * c0v + v0 * s0v; v0 = r0; v1 = r1; }
                    if (kind == 0) { v0 = v0 * QSCALE; v1 = v1 * QSCALE; bf16_t* o = Q + row * DATT + c0; *(u32x2*)o = pack4(v0); *(u32x2*)(o + 16) = pack4(v1); }
                    else if (kind == 1) {
                        if (!lat) { float* so = sk + row * DATT + c0; *(f32x4*)so = v0; *(f32x4*)(so + 16) = v1; bf16_t* o = Kc + row * DATT + c0; *(u32x2*)o = pack4(v0); *(u32x2*)(o + 16) = pack4(v1); }
                        else { bf16_t* o = Kl + ((size_t)b * TALL + PAST + t) * DATT + c0; *(u32x2*)o = pack4(v0); *(u32x2*)(o + 16) = pack4(v1); }
                    } else if (kind == 2) {
                        const int head = (u.pn & 3) * 2 + bj, dcol = wc * 32 + fq * 4;
                        if (!lat) { float* so = sv + row * DATT + c0; *(f32x4*)so = v0; *(f32x4*)(so + 16) = v1;
                            bf16_t* o = Vtc + ((size_t)(b * 8 + head) * 128 + dcol) * TCTX + t;
#pragma unroll
                            for (int i = 0; i < 4; ++i) { o[(size_t)i * TCTX] = bf1(v0[i]); o[(size_t)(i + 16) * TCTX] = bf1(v1[i]); } }
                        else { bf16_t* o = Vtl + ((size_t)(b * 8 + head) * 128 + dcol) * TALL + PAST + t;
#pragma unroll
                            for (int i = 0; i < 4; ++i) { o[(size_t)i * TALL] = bf1(v0[i]); o[(size_t)(i + 16) * TALL] = bf1(v1[i]); } }
                    } else { bf16_t* o = P + row * DATT + c0; *(u32x2*)o = pack4(v0); *(u32x2*)(o + 16) = pack4(v1); }
                }
            }
    }
};
struct EpiResid {
    static constexpr bool PERM = false, AFTER_DRAIN = false;
    const float *xa, *xb; float* out; const float* gate;
    __device__ __forceinline__ void operator()(const f32x4 (&acc)[2][2][4][2], const Unit& u, int wr, int wc, int fr, int fq) const {
        const int bidx = u.pm < 16 ? 8 : ((u.pm - 16) >> 3);
        const float* gp = gate + (size_t)bidx * NMOD + u.pn * BM + wc * 32 + fq * 4;
        f32x4 gv[2][2];
#pragma unroll
        for (int bj = 0; bj < 2; ++bj)
#pragma unroll
            for (int n = 0; n < 2; ++n) gv[bj][n] = *(const f32x4*)(gp + bj * HALF + n * 16);
#pragma unroll
        for (int ai = 0; ai < 2; ++ai)
#pragma unroll
            for (int m = 0; m < 4; ++m) {
                const size_t row = (size_t)u.pm * BM + ai * HALF + wr * 64 + m * 16 + fr;
                const float* xr = (row < (size_t)NCTX ? xa + row * DM : xb + (row - NCTX) * DM) + u.pn * BM + wc * 32 + fq * 4;
                float* orow = out + row * DM + u.pn * BM + wc * 32 + fq * 4;
#pragma unroll
                for (int bj = 0; bj < 2; ++bj)
#pragma unroll
                    for (int n = 0; n < 2; ++n) { const f32x4 xv = *(const f32x4*)(xr + bj * HALF + n * 16); *(f32x4*)(orow + bj * HALF + n * 16) = xv + gv[bj][n] * acc[ai][bj][m][n]; }
            }
    }
};
struct EpiGateBf16 {
    static constexpr bool PERM = false, AFTER_DRAIN = false;
    bf16_t* dst; const float* gate;
    __device__ __forceinline__ void operator()(const f32x4 (&acc)[2][2][4][2], const Unit& u, int wr, int wc, int fr, int fq) const {
        const int bidx = u.pm < 16 ? 8 : ((u.pm - 16) >> 3);
        const int cofs = u.pn * BM + wc * 32 + fq * 4;
        const float* gp = gate + (size_t)bidx * NMOD + cofs;
        bf16_t* o0 = dst + ((size_t)u.pm * BM + wr * 64 + fr) * DM + cofs;
#pragma unroll
        for (int bj = 0; bj < 2; ++bj)
#pragma unroll
            for (int n = 0; n < 2; ++n) {
                const f32x4 gv = *(const f32x4*)(gp + bj * HALF + n * 16);
#pragma unroll
                for (int ai = 0; ai < 2; ++ai)
#pragma unroll
                    for (int m = 0; m < 4; ++m) *(u32x2*)(o0 + (size_t)(ai * HALF + m * 16) * DM + bj * HALF + n * 16) = pack4(acc[ai][bj][m][n] * gv);
            }
    }
};
struct EpiPool {
    static constexpr bool PERM = false, AFTER_DRAIN = false;
    bf16_t* am; const float* scale;
    __device__ __forceinline__ void operator()(const f32x4 (&acc)[2][2][4][2], const Unit& u, int wr, int wc, int fr, int fq) const {
        const int cbase = u.pn * BM + wc * 32 + fq * 4;
        bf16_t* o0 = am + ((size_t)u.pm * BM + wr * 64 + fr) * DM + DATT + cbase;
#pragma unroll
        for (int bj = 0; bj < 2; ++bj)
#pragma unroll
            for (int n = 0; n < 2; ++n) {
                const f32x4 sv = *(const f32x4*)(scale + cbase + bj * HALF + n * 16);
#pragma unroll
                for (int ai = 0; ai < 2; ++ai)
#pragma unroll
                    for (int m = 0; m < 4; ++m) *(u32x2*)(o0 + (size_t)(ai * HALF + m * 16) * DM + bj * HALF + n * 16) = pack4(acc[ai][bj][m][n] * sv);
            }
    }
};
#define DPP_F(v, ctrl) __builtin_bit_cast(float, __builtin_amdgcn_update_dpp(0, __builtin_bit_cast(int, (v)), (ctrl), 0xf, 0xf, true))
#ifndef USE_DPP
#define USE_DPP 0
#endif
#if USE_DPP
__device__ __forceinline__ f32x4 dpp_shr1(f32x4 v)  { return (f32x4){DPP_F(v[0], 0x111), DPP_F(v[1], 0x111), DPP_F(v[2], 0x111), DPP_F(v[3], 0x111)}; }
__device__ __forceinline__ f32x4 dpp_shl1(f32x4 v)  { return (f32x4){DPP_F(v[0], 0x101), DPP_F(v[1], 0x101), DPP_F(v[2], 0x101), DPP_F(v[3], 0x101)}; }
__device__ __forceinline__ f32x4 dpp_shl15(f32x4 v) { return (f32x4){DPP_F(v[0], 0x10F), DPP_F(v[1], 0x10F), DPP_F(v[2], 0x10F), DPP_F(v[3], 0x10F)}; }
__device__ __forceinline__ f32x4 dpp_shr15(f32x4 v) { return (f32x4){DPP_F(v[0], 0x11F), DPP_F(v[1], 0x11F), DPP_F(v[2], 0x11F), DPP_F(v[3], 0x11F)}; }
#else
__device__ __forceinline__ f32x4 shfl_sel(f32x4 v, int src, bool ok) { f32x4 o;
#pragma unroll
    for (int i = 0; i < 4; ++i) { const float t = __shfl(v[i], src); o[i] = ok ? t : 0.f; } return o; }
__device__ __forceinline__ f32x4 dpp_shr1(f32x4 v)  { const int l = threadIdx.x & 63; return shfl_sel(v, l - 1, (l & 15) != 0); }
__device__ __forceinline__ f32x4 dpp_shl1(f32x4 v)  { const int l = threadIdx.x & 63; return shfl_sel(v, l + 1, (l & 15) != 15); }
__device__ __forceinline__ f32x4 dpp_shl15(f32x4 v) { const int l = threadIdx.x & 63; return shfl_sel(v, l + 15, (l & 15) == 0); }
__device__ __forceinline__ f32x4 dpp_shr15(f32x4 v) { const int l = threadIdx.x & 63; return shfl_sel(v, l - 15, (l & 15) == 15); }
#endif
__device__ __forceinline__ f32x4 silu_mul(f32x4 g, f32x4 v) {
    f32x4 o;
#pragma unroll
    for (int i = 0; i < 4; ++i) { const float e = __builtin_amdgcn_exp2f(-g[i] * 1.4426950408889634f); o[i] = g[i] * __builtin_amdgcn_rcpf(1.0f + e) * v[i]; }
    return o;
}
struct EpiUp {
    static constexpr bool PERM = false, AFTER_DRAIN = false;
    bf16_t* act; float* ebuf; const float* ck; const float* cbias; PG8_LAS float* xl;
    __device__ __forceinline__ void operator()(const f32x4 (&acc)[2][2][4][2], const Unit& u, int wr, int wc, int fr, int fq) const {
        const int colw = wc * 32 + fq * 4;
#pragma unroll
        for (int ai = 0; ai < 2; ++ai)
#pragma unroll
            for (int bj = 0; bj < 2; ++bj)
#pragma unroll
                for (int n = 0; n < 2; ++n) { const int col = bj * HALF + n * 16 + colw, rb = ai * 2 + wr;
                    if (fr == 0) *(PG8_LAS f32x4*)(xl + (rb * 2) * 256 + col) = acc[ai][bj][0][n];
                    if (fr == 15) *(PG8_LAS f32x4*)(xl + (rb * 2 + 1) * 256 + col) = acc[ai][bj][3][n]; }
        float* eb = ebuf + (size_t)u.pm * 4 * NUP + u.pn * BM + colw;
        if (wr == 0 && fr < 2) {
#pragma unroll
            for (int bj = 0; bj < 2; ++bj)
#pragma unroll
                for (int n = 0; n < 2; ++n) *(f32x4*)(eb + (size_t)fr * NUP + bj * HALF + n * 16) = acc[0][bj][0][n]; }
        if (wr == 1 && fr >= 14) {
#pragma unroll
            for (int bj = 0; bj < 2; ++bj)
#pragma unroll
                for (int n = 0; n < 2; ++n) *(f32x4*)(eb + (size_t)(fr - 12) * NUP + bj * HALF + n * 16) = acc[1][bj][3][n]; }
        asm volatile("s_waitcnt lgkmcnt(0)" ::: "memory"); __builtin_amdgcn_s_barrier(); asm volatile("" ::: "memory");
#pragma unroll
        for (int n = 0; n < 2; ++n) {
            const int gc = u.pn * HALF + n * 16 + colw;
            const f32x4 k0g = *(const f32x4*)(ck + gc), k1g = *(const f32x4*)(ck + NUP + gc), k2g = *(const f32x4*)(ck + 2 * NUP + gc), bg = *(const f32x4*)(cbias + gc);
            const f32x4 k0v = *(const f32x4*)(ck + DFF + gc), k1v = *(const f32x4*)(ck + NUP + DFF + gc), k2v = *(const f32x4*)(ck + 2 * NUP + DFF + gc), bv = *(const f32x4*)(cbias + DFF + gc);
#pragma unroll
            for (int ai = 0; ai < 2; ++ai) {
                const int rb = ai * 2 + wr; const f32x4 z4 = {0.f, 0.f, 0.f, 0.f};
                const int l_ = threadIdx.x & 63, srcR = (l_ & 48) | ((l_ - 1) & 15), srcL = (l_ & 48) | ((l_ + 1) & 15);
                int Rp[4] = {0, 0, 0, 0}, Lc[4], Ln[4] = {0, 0, 0, 0};
#pragma unroll
                for (int i = 0; i < 4; ++i) Lc[i] = __shfl((int)cvtpk(acc[ai][0][0][n][i], acc[ai][1][0][n][i]), srcL);
#pragma unroll
                for (int m = 0; m < 4; ++m) {
                    const f32x4 cg_ = acc[ai][0][m][n], cv_ = acc[ai][1][m][n];
                    int Rc[4];
#pragma unroll
                    for (int i = 0; i < 4; ++i) Rc[i] = __shfl((int)cvtpk(cg_[i], cv_[i]), srcR);
                    if (m < 3) {
#pragma unroll
                        for (int i = 0; i < 4; ++i) Ln[i] = __shfl((int)cvtpk(acc[ai][0][m < 3 ? m + 1 : 3][n][i], acc[ai][1][m < 3 ? m + 1 : 3][n][i]), srcL); }
                    f32x4 ug, uv, dg, dv;
#pragma unroll
                    for (int i = 0; i < 4; ++i) {
                        const unsigned up = (unsigned)(fr > 0 ? Rc[i] : Rp[i]), dn = (unsigned)(fr < 15 ? Lc[i] : Ln[i]);
                        ug[i] = __builtin_bit_cast(float, up << 16); uv[i] = __builtin_bit_cast(float, up & 0xffff0000u);
                        dg[i] = __builtin_bit_cast(float, dn << 16); dv[i] = __builtin_bit_cast(float, dn & 0xffff0000u);
                        Rp[i] = Rc[i]; Lc[i] = Ln[i];
                    }
                    if (m == 0 && fr == 0) { ug = z4; uv = z4; if (rb > 0) { ug = *(const PG8_LAS f32x4*)(xl + ((rb - 1) * 2 + 1) * 256 + n * 16 + colw); uv = *(const PG8_LAS f32x4*)(xl + ((rb - 1) * 2 + 1) * 256 + HALF + n * 16 + colw); } }
                    if (m == 3 && fr == 15) { dg = z4; dv = z4; if (rb < 3) { dg = *(const PG8_LAS f32x4*)(xl + ((rb + 1) * 2) * 256 + n * 16 + colw); dv = *(const PG8_LAS f32x4*)(xl + ((rb + 1) * 2) * 256 + HALF + n * 16 + colw); } }
                    const f32x4 gg = k0g * ug + k1g * cg_ + k2g * dg + bg, vv = k0v * uv + k1v * cv_ + k2v * dv + bv;
                    const size_t row = (size_t)u.pm * BM + ai * HALF + wr * 64 + m * 16 + fr;
                    *(u32x2*)(act + row * DFF + gc) = pack4(silu_mul(gg, vv));
                }
            }
        }
    }
};
}
#define LAS __attribute__((address_space(3)))
typedef unsigned short bf16;
typedef float f32x4 __attribute__((ext_vector_type(4)));
typedef float f32x16 __attribute__((ext_vector_type(16)));
typedef short bf16x8 __attribute__((ext_vector_type(8)));
typedef short s16x4 __attribute__((ext_vector_type(4)));
typedef unsigned u32x4 __attribute__((ext_vector_type(4)));
typedef unsigned u32x2 __attribute__((ext_vector_type(2)));
using pg8::cvtpk; using pg8::pack4;
__device__ __forceinline__ float wave_sum(float v) {
#pragma unroll
    for (int o = 1; o < 64; o <<= 1) v += __shfl_xor(v, o);
    return v;
}
__device__ __forceinline__ float bf_lo(unsigned w) { return __builtin_bit_cast(float, w << 16); }
__device__ __forceinline__ float bf_hi(unsigned w) { return __builtin_bit_cast(float, w & 0xffff0000u); }
__device__ __forceinline__ float half_max(float v) { return fmaxf(v, __shfl_xor(v, 32)); }
__device__ __forceinline__ float half_sum(float v) { return v + __shfl_xor(v, 32); }

constexpr size_t MiB = 1u << 20;
constexpr size_t WS_CTL = 0, CTL_ZERO_BYTES = 32768;
constexpr size_t WS_MOD = 1 * MiB, WS_ROPE = 2 * MiB;
constexpr size_t WS_WIN = 4 * MiB, WS_WOUT = 20 * MiB, WS_WUP = 28 * MiB, WS_WDOWN = 71 * MiB, WS_WPOOL = 93 * MiB;
constexpr size_t WS_H = 94 * MiB, WS_Q = 174 * MiB, WS_KC = 214 * MiB, WS_KL = 222 * MiB, WS_VTC = 262 * MiB, WS_VTL = 270 * MiB, WS_P = 310 * MiB, WS_POOLED = 350 * MiB;
constexpr size_t WS_AM = 390 * MiB, WS_EBUF = 470 * MiB, WS_ACT = 174 * MiB, WS_END = 484 * MiB;
static_assert(WS_ACT + (size_t)MROWS * DFF * 2 <= WS_AM, "act overlay");
static_assert(WS_EBUF + (size_t)80 * 4 * NUP * 4 <= WS_END, "ebuf");
constexpr int RING_BYTES = 131072, XL_OFF = RING_BYTES, LDS_BYTES = 147456;

__device__ __forceinline__ void transpose_item(const float* W, int ldw, int k0, int n0, bf16* WT, int ldt, int drow0, LAS float* scr, int lane) {
    float tv[32];
#pragma unroll
    for (int i = 0; i < 32; ++i) tv[i] = W[(size_t)(k0 + 2 * i + (lane >> 5)) * ldw + n0 + (lane & 31)];
#pragma unroll
    for (int i = 0; i < 32; ++i) scr[(2 * i + (lane >> 5)) * 33 + (lane & 31)] = tv[i];
    asm volatile("s_waitcnt lgkmcnt(0)" ::: "memory");
    const int c = lane & 7;
#pragma unroll
    for (int j = 0; j < 4; ++j) { const int n = (lane >> 3) + 8 * j; const LAS float* s = scr + (8 * c) * 33 + n;
        u32x4 o; o.x = cvtpk(s[0 * 33], s[1 * 33]); o.y = cvtpk(s[2 * 33], s[3 * 33]); o.z = cvtpk(s[4 * 33], s[5 * 33]); o.w = cvtpk(s[6 * 33], s[7 * 33]);
        *(u32x4*)(WT + (size_t)(drow0 + n) * ldt + k0 + 8 * c) = o; }
    asm volatile("s_waitcnt lgkmcnt(0)" ::: "memory");
}
constexpr int IT_WIN = (DM / 64) * (DIN / 32), IT_WOUT = (DM / 64) * (DM / 32), IT_WUP = (DM / 64) * (NUP / 32), IT_WDOWN = (DFF / 64) * (DM / 32), IT_WPOOL = 4 * 4 * 8,
              IT_CV = 8 * (PAST / 64) * (DATT / 32), IT_CK = 8 * PAST;
constexpr int IT_TOTAL = IT_WIN + IT_WOUT + IT_WUP + IT_WPOOL + IT_CV + IT_CK + IT_WDOWN;

struct Args { const float* in[24]; float* outp; unsigned char* wsp; };

__device__ __forceinline__ void norm_row(const float* xrow, const float* g, const float* sc, const float* sh, bf16* outb, float* outf, int lane, const bf16* addb = nullptr, const bf16* addc = nullptr) {
    const f32x4* xr = (const f32x4*)xrow + lane;
    f32x4 v[8]; float s = 0.f;
#pragma unroll
    for (int j = 0; j < 8; ++j) { v[j] = xr[64 * j];
        if (addb) { const u32x2 d_ = ((const u32x2*)addb + lane)[64 * j]; v[j] += (f32x4){bf_lo(d_.x), bf_hi(d_.x), bf_lo(d_.y), bf_hi(d_.y)}; }
        if (addc) { const u32x2 d_ = ((const u32x2*)addc + lane)[64 * j]; v[j] += (f32x4){bf_lo(d_.x), bf_hi(d_.x), bf_lo(d_.y), bf_hi(d_.y)}; }
        s += (v[j].x * v[j].x + v[j].y * v[j].y) + (v[j].z * v[j].z + v[j].w * v[j].w); }
    const float rstd = 1.0f / sqrtf(wave_sum(s) * (1.0f / DM) + EPS);
#pragma unroll
    for (int j = 0; j < 8; ++j) {
        const int c = 4 * lane + 256 * j;
        f32x4 y = v[j] * rstd * *(const f32x4*)(g + c);
        if (sc) y = y * (1.0f + *(const f32x4*)(sc + c)) + *(const f32x4*)(sh + c);
        if (outb) *(u32x2*)(outb + c) = pack4(y); else *(f32x4*)(outf + c) = y;
    }
}

template <int HW> __device__ __forceinline__ void pool_item(const bf16* base, bf16* obase, int t0, int T) {
    constexpr int NR = 7 + 2 * HW;
    u32x4 rows[NR];
#pragma unroll
    for (int j = 0; j < NR; ++j) { const int tt = t0 - HW + j; rows[j] = (tt >= 0 && tt < T) ? *(const u32x4*)(base + (size_t)tt * DATT) : (u32x4){0u, 0u, 0u, 0u}; }
    float s[8];
#pragma unroll
    for (int i = 0; i < 8; ++i) s[i] = 0.f;
#define POOL_ADD(SGN, v_) { s[0] SGN bf_lo(v_.x); s[1] SGN bf_hi(v_.x); s[2] SGN bf_lo(v_.y); s[3] SGN bf_hi(v_.y); s[4] SGN bf_lo(v_.z); s[5] SGN bf_hi(v_.z); s[6] SGN bf_lo(v_.w); s[7] SGN bf_hi(v_.w); }
#pragma unroll
    for (int j = 0; j < 2 * HW; ++j) POOL_ADD(+=, rows[j])
#pragma unroll
    for (int i = 0; i < 8; ++i) {
        const int t = t0 + i, lo = max(t - HW, 0), hi = min(t + HW, T); const float ic = 1.0f / (float)(hi - lo); const u32x4 ov = rows[i + HW];
        u32x4 w; w.x = cvtpk(s[0] * ic - bf_lo(ov.x), s[1] * ic - bf_hi(ov.x)); w.y = cvtpk(s[2] * ic - bf_lo(ov.y), s[3] * ic - bf_hi(ov.y));
        w.z = cvtpk(s[4] * ic - bf_lo(ov.z), s[5] * ic - bf_hi(ov.z)); w.w = cvtpk(s[6] * ic - bf_lo(ov.w), s[7] * ic - bf_hi(ov.w));
        *(u32x4*)(obase + (size_t)t * DATT) = w;
        if (i < 7) { POOL_ADD(+=, rows[i + 2 * HW]) POOL_ADD(-=, rows[i]) }
    }
#undef POOL_ADD
}

namespace att {
constexpr int KSTRB = 272, VSTRB = 144, KBYTES = 64 * KSTRB, VBYTES = 128 * VSTRB, V_OFF = 2 * KBYTES, OX_OFF = 0;
static_assert(V_OFF + 3 * VBYTES <= 131072 && 65536 <= 131072, "attention LDS");
__device__ __forceinline__ int crow(int r, int hi) { return (r & 3) + 8 * (r >> 2) + 4 * hi; }
__device__ __forceinline__ void pv_tile(f32x16 (&o)[4], LAS unsigned char* vbase, const bf16x8 (&pb)[4]) {
#pragma unroll
    for (int ks = 0; ks < 4; ++ks) {
        bf16x8 vf[4];
#pragma unroll
        for (int d = 0; d < 4; ++d) vf[d] = *(const LAS bf16x8*)(vbase + d * 32 * VSTRB + ks * 32);
#pragma unroll
        for (int d = 0; d < 4; ++d) o[d] = __builtin_amdgcn_mfma_f32_32x32x16_bf16(vf[d], pb[ks], o[d], 0, 0, 0);
    }
}
__device__ __forceinline__ void unit(LAS unsigned char* lds, const bf16* Qp, const bf16* Kg, const bf16* Vtg, int tall, int nt, bf16* Op, float lam, const float* subg) {
    const int tid = threadIdx.x, lane = tid & 63, r = lane & 31, hi = lane >> 5, wid = __builtin_amdgcn_readfirstlane(tid >> 6), rg = wid & 3, mp = wid >> 2;
    bf16x8 qf[4];
    { const bf16* qp = Qp + (size_t)(rg * 32 + r) * DATT + mp * 64 + hi * 8;
#pragma unroll
      for (int s = 0; s < 4; ++s) qf[s] = *(const bf16x8*)(qp + 16 * s); }
    f32x16 o[4];
#pragma unroll
    for (int d = 0; d < 4; ++d)
#pragma unroll
        for (int i = 0; i < 16; ++i) o[d][i] = 0.f;
    float m_run = 0.f, l_run = 0.f;
    const bf16* ksrc[2]; const bf16* vsrc[2]; int kdst[2], vdst[2];
#pragma unroll
    for (int i = 0; i < 2; ++i) { const int id = tid + 512 * i; ksrc[i] = Kg + (size_t)(id >> 4) * DATT + (id & 15) * 8; kdst[i] = (id >> 4) * KSTRB + (id & 15) * 16;
        vsrc[i] = Vtg + (size_t)(id >> 3) * tall + (id & 7) * 8; vdst[i] = V_OFF + (id >> 3) * VSTRB + ((id & 7) >> 1) * 32 + (id & 1) * 8; }
    u32x4 kr[2], vr[2];
#pragma unroll
    for (int i = 0; i < 2; ++i) { kr[i] = *(const u32x4*)ksrc[i]; vr[i] = *(const u32x4*)vsrc[i]; }
#pragma unroll
    for (int i = 0; i < 2; ++i) { *(LAS u32x4*)(lds + kdst[i]) = kr[i]; *(LAS u32x2*)(lds + vdst[i]) = (u32x2){vr[i].x, vr[i].y}; *(LAS u32x2*)(lds + vdst[i] + 16) = (u32x2){vr[i].z, vr[i].w}; }
    __syncthreads();
    const int koff = r * KSTRB + (mp * 64 + hi * 8) * 2, voff = V_OFF + r * VSTRB + hi * 16;
    bf16x8 pb[4];
#pragma unroll
    for (int i = 0; i < 4; ++i) pb[i] = (bf16x8){0, 0, 0, 0, 0, 0, 0, 0};
    int vcur = 0, vprev = 0;
    for (int t = 0; t < nt; ++t) {
        const int kcur = (t & 1) * KBYTES, knxt = KBYTES - kcur, vnxt = (vcur == 2 * VBYTES) ? 0 : vcur + VBYTES;
        if (t + 1 < nt) {
#pragma unroll
            for (int i = 0; i < 2; ++i) { kr[i] = *(const u32x4*)(ksrc[i] + (size_t)(t + 1) * 64 * DATT); vr[i] = *(const u32x4*)(vsrc[i] + (t + 1) * 64); }
        }
        f32x16 p0, p1;
#define ATT_QK(C0) { _Pragma("unroll") for (int i = 0; i < 16; ++i) { p0[i] = 0.f; p1[i] = 0.f; } _Pragma("unroll") for (int s = 0; s < 4; ++s) { \
            const bf16x8 a0 = *(const LAS bf16x8*)(lds + kcur + koff + s * 32), a1 = *(const LAS bf16x8*)(lds + kcur + koff + 32 * KSTRB + s * 32); \
            p0 = __builtin_amdgcn_mfma_f32_32x32x16_bf16(a0, qf[s], p0, 0, 0, 0); p1 = __builtin_amdgcn_mfma_f32_32x32x16_bf16(a1, qf[s], p1, 0, 0, 0); } }
#define ATT_ROWMAX(mx) { mx = fmaxf(p0[0], p1[0]); _Pragma("unroll") for (int i = 1; i < 16; ++i) mx = fmaxf(mx, fmaxf(p0[i], p1[i])); mx = half_max(mx); }
        float rs;
        for (bool redo = false;;) {
            ATT_QK(0)
            if (t == 0 || redo) {
                float mx; ATT_ROWMAX(mx)
                if (t != 0) { mx = fmaxf(mx - m_run, 0.f); const float alpha = __builtin_amdgcn_exp2f(-mx); l_run *= alpha;
#pragma unroll
                    for (int d = 0; d < 4; ++d)
#pragma unroll
                        for (int i = 0; i < 16; ++i) o[d][i] *= alpha; }
                m_run += mx;
            }
            rs = 0.f;
#pragma unroll
            for (int i = 0; i < 16; ++i) { p0[i] = __builtin_amdgcn_exp2f(p0[i] - m_run); p1[i] = __builtin_amdgcn_exp2f(p1[i] - m_run); rs += p0[i] + p1[i]; }
            if (redo || !__any(!(rs < 1e18f))) break;
            redo = true;
        }
        l_run += rs;
#undef ATT_QK
#undef ATT_ROWMAX
#pragma unroll
        for (int s = 0; s < 2; ++s) {
            u32x4 w0, w1;
            w0.x = cvtpk(p0[8 * s + 0], p0[8 * s + 1]); w0.y = cvtpk(p0[8 * s + 2], p0[8 * s + 3]); w0.z = cvtpk(p0[8 * s + 4], p0[8 * s + 5]); w0.w = cvtpk(p0[8 * s + 6], p0[8 * s + 7]);
            w1.x = cvtpk(p1[8 * s + 0], p1[8 * s + 1]); w1.y = cvtpk(p1[8 * s + 2], p1[8 * s + 3]); w1.z = cvtpk(p1[8 * s + 4], p1[8 * s + 5]); w1.w = cvtpk(p1[8 * s + 6], p1[8 * s + 7]);
            pb[s] = __builtin_bit_cast(bf16x8, w0); pb[2 + s] = __builtin_bit_cast(bf16x8, w1);
        }
        pv_tile(o, lds + vcur + voff, pb);
        __builtin_amdgcn_iglp_opt(0);
        if (t + 1 < nt) {
#pragma unroll
            for (int i = 0; i < 2; ++i) { *(LAS u32x4*)(lds + knxt + kdst[i]) = kr[i]; *(LAS u32x2*)(lds + vnxt + vdst[i]) = (u32x2){vr[i].x, vr[i].y}; *(LAS u32x2*)(lds + vnxt + vdst[i] + 16) = (u32x2){vr[i].z, vr[i].w}; }
        }
        vprev = vcur; vcur = vnxt;
        __syncthreads();
    }
    __syncthreads();
    const float inv = 1.0f / half_sum(l_run);
    LAS float* ox = (LAS float*)(lds + OX_OFF) + rg * 4096 + lane;
    if (mp == 1) {
        const float f = inv * lam;
#pragma unroll
        for (int d = 0; d < 4; ++d)
#pragma unroll
            for (int i = 0; i < 16; ++i) ox[(d * 16 + i) * 64] = o[d][i] * f;
    }
    __syncthreads();
    if (mp == 0) {
        float ss = 0.f;
#pragma unroll
        for (int d = 0; d < 4; ++d)
#pragma unroll
            for (int i = 0; i < 16; ++i) { const float a = o[d][i] * inv - ox[(d * 16 + i) * 64]; o[d][i] = a; ss += a * a; }
        ss = half_sum(ss);
        const float rn = (1.0f / sqrtf(ss * (1.0f / 128.0f) + EPS)) * 0.8f;
        bf16* orow = Op + (size_t)(rg * 32 + r) * DM;
#pragma unroll
        for (int d = 0; d < 4; ++d)
#pragma unroll
            for (int g = 0; g < 4; ++g) { const int d0 = 32 * d + 8 * g + 4 * hi; const f32x4 gv = *(const f32x4*)(subg + d0);
                const f32x4 y = {o[d][4 * g] * rn * gv[0], o[d][4 * g + 1] * rn * gv[1], o[d][4 * g + 2] * rn * gv[2], o[d][4 * g + 3] * rn * gv[3]};
                *(u32x2*)(orow + d0) = pack4(y); }
    }
    __syncthreads();
}
}

constexpr int ARGS_OFF = 147200;
__device__ __forceinline__ void* ldarg(LAS unsigned char* lds, int i) {
    const unsigned long long v = ((const LAS unsigned long long*)(lds + ARGS_OFF))[i];
    const unsigned lo = __builtin_amdgcn_readfirstlane((unsigned)v), hi = __builtin_amdgcn_readfirstlane((unsigned)(v >> 32));
    return (void*)(__attribute__((address_space(1))) void*)(((unsigned long long)hi << 32) | lo);
}
#define LDARG(i) ldarg(lds, (i))
#define x_prompt ((const float*)LDARG(0))
#define x_sample ((const float*)LDARG(1))
#define cin ((const float*)LDARG(2))
#define cache_k ((const float*)LDARG(3))
#define cache_v ((const float*)LDARG(4))
#define c_ctx ((const float*)LDARG(5))
#define w_ada ((const float*)LDARG(6))
#define b_ada ((const float*)LDARG(7))
#define norm1_g ((const float*)LDARG(8))
#define w_in ((const float*)LDARG(9))
#define lam_q1 ((const float*)LDARG(10))
#define lam_k1 ((const float*)LDARG(11))
#define lam_q2 ((const float*)LDARG(12))
#define lam_k2 ((const float*)LDARG(13))
#define subln_g ((const float*)LDARG(14))
#define w_pool ((const float*)LDARG(15))
#define pool_scale ((const float*)LDARG(16))
#define w_out ((const float*)LDARG(17))
#define norm2_g ((const float*)LDARG(18))
#define w_up ((const float*)LDARG(19))
#define conv_k ((const float*)LDARG(20))
#define conv_b ((const float*)LDARG(21))
#define w_down ((const float*)LDARG(22))
#define norm_f_g ((const float*)LDARG(23))
#define out ((float*)LDARG(24))
#define ws ((unsigned char*)LDARG(25))
#define state_k (out + (size_t)MROWS * DM)
#define state_v (out + (size_t)MROWS * DM + (size_t)NCTX * DATT)
#define ctl ((unsigned*)(ws + WS_CTL))
#define mod ((float*)(ws + WS_MOD))
#define rope ((float*)(ws + WS_ROPE))
#define WinT ((bf16*)(ws + WS_WIN))
#define WoutT ((bf16*)(ws + WS_WOUT))
#define WupT ((bf16*)(ws + WS_WUP))
#define WdownT ((bf16*)(ws + WS_WDOWN))
#define WpoolT ((bf16*)(ws + WS_WPOOL))
#define Hb ((bf16*)(ws + WS_H))
#define Qb ((bf16*)(ws + WS_Q))
#define Kc ((bf16*)(ws + WS_KC))
#define Kl ((bf16*)(ws + WS_KL))
#define Vtc ((bf16*)(ws + WS_VTC))
#define Vtl ((bf16*)(ws + WS_VTL))
#define Pb ((bf16*)(ws + WS_P))
#define Pooled ((bf16*)(ws + WS_POOLED))
#define AM ((bf16*)(ws + WS_AM))
#define ACT ((bf16*)(ws + WS_ACT))
#define ebuf ((float*)(ws + WS_EBUF))
#define RLX_AGENT __ATOMIC_RELAXED, __HIP_MEMORY_SCOPE_AGENT
#define XB_TMO      128
#define XB_XCNT(j)  (256  + 64 * (j))
#define XB_XSUB(j)  (1280 + 64 * (j))
#define XB_XGEN(j)  (2304 + 64 * (j))
#define XB_TOP      3328
#define XB_TOPGEN   3392
#define XCD_BAR_WORDS 3456
#define XB_SPIN_CAP (1u << 18)

__device__ __forceinline__ unsigned xb_ld(unsigned* p)              { return __hip_atomic_load(p, __ATOMIC_RELAXED, __HIP_MEMORY_SCOPE_AGENT); }
__device__ __forceinline__ unsigned xb_add(unsigned* p, unsigned v) { return __hip_atomic_fetch_add(p, v, __ATOMIC_RELAXED, __HIP_MEMORY_SCOPE_AGENT); }
__device__ __forceinline__ unsigned xb_xcc_id() { return (unsigned)__builtin_amdgcn_s_getreg((3 << 11) | 20) & 0xFu; }
#define XB_SPIN(cond, bar) do { unsigned _sp = 0; while (cond) { __builtin_amdgcn_s_sleep(1); \
    if ((++_sp & 255u) == 0u) { if (xb_ld(&(bar)[XB_TMO])) break; if (_sp > XB_SPIN_CAP) { atomicAdd(&(bar)[XB_TMO], 1u); break; } } } } while (0)

struct XcdBarrier {
    unsigned* bar; unsigned x;
    volatile LAS unsigned* st;
};

__device__ __forceinline__ XcdBarrier xcd_barrier_post(unsigned* bar, volatile LAS unsigned* st) {
    XcdBarrier b; b.bar = bar; b.x = xb_xcc_id(); b.st = st;
    if (threadIdx.x == 0) (void)xb_add(&bar[XB_XCNT(b.x)], 1u);
    return b;
}
__device__ __forceinline__ void xcd_barrier_complete(unsigned* bar, unsigned x, unsigned& nloc, unsigned& nx) {
    const unsigned G = gridDim.x * gridDim.y * gridDim.z;
    unsigned sum, cnt, mine, sp = 0u;
    for (;;) {
        sum = 0u; cnt = 0u; mine = 0u;
#pragma unroll
        for (unsigned j = 0; j < 16; ++j) { const unsigned c = xb_ld(&bar[XB_XCNT(j)]); sum += c; cnt += (c > 0u) ? 1u : 0u; mine = (j == x) ? c : mine; }
        if (sum == G) break;
        __builtin_amdgcn_s_sleep(1);
        if ((++sp & 255u) == 0u) { if (xb_ld(&bar[XB_TMO])) break; if (sp > XB_SPIN_CAP) { atomicAdd(&bar[XB_TMO], 1u); break; } }
    }
    nloc = mine > 0u ? mine : 1u; nx = cnt > 0u ? cnt : 1u;
}

__device__ __forceinline__ void xcd_barrier(const XcdBarrier& b) {
    asm volatile("s_waitcnt vmcnt(0)" ::: "memory");
    __syncthreads();
    if (threadIdx.x == 0) {
        unsigned* bar = b.bar;
        __builtin_amdgcn_s_waitcnt(0);
        unsigned nloc = b.st[0], nx = b.st[1];
        if (nloc == 0u) { xcd_barrier_complete(bar, b.x, nloc, nx); b.st[0] = nloc; b.st[1] = nx; }
        const unsigned old = xb_add(&bar[XB_XSUB(b.x)], 1u);
        const unsigned gen = old / nloc;
        if (old + 1u == (gen + 1u) * nloc) {
            __builtin_amdgcn_fence(__ATOMIC_RELEASE, "agent");
            asm volatile("s_waitcnt vmcnt(0)" ::: "memory");
            const unsigned og = xb_add(&bar[XB_TOP], 1u);
            const unsigned tg = og / nx;
            if (og + 1u == (tg + 1u) * nx) xb_add(&bar[XB_TOPGEN], 1u);
            else XB_SPIN(xb_ld(&bar[XB_TOPGEN]) == tg, bar);
            __builtin_amdgcn_fence(__ATOMIC_ACQUIRE, "agent");
            xb_add(&bar[XB_XGEN(b.x)], 1u);
            asm volatile("s_waitcnt vmcnt(0)" ::: "memory");
        } else {
            XB_SPIN(xb_ld(&bar[XB_XGEN(b.x)]) == gen, bar);
            __builtin_amdgcn_fence(__ATOMIC_ACQUIRE, "agent");
            asm volatile("s_waitcnt vmcnt(0)" ::: "memory");
        }
    }
    __syncthreads();
}

constexpr int CW_BAR = 1024, MISC_OFF = 147416;
struct MidBar { LAS unsigned char* lds; int at;
    __device__ __forceinline__ void operator()(int ui) const { if (ui == at) { XcdBarrier b_; b_.bar = (unsigned*)((unsigned char*)ldarg(lds, 25) + WS_CTL) + CW_BAR; b_.x = xb_xcc_id(); b_.st = (volatile LAS unsigned*)(lds + MISC_OFF); xcd_barrier(b_); } } };
__global__ void __launch_bounds__(512, 2) fwd_kernel(Args args) {
    extern __shared__ __attribute__((aligned(16))) unsigned char lds_raw[];
    LAS unsigned char* lds = (LAS unsigned char*)lds_raw;
    cg::grid_group grid = cg::this_grid();
    const int tid = threadIdx.x, lane = tid & 63, wave = __builtin_amdgcn_readfirstlane(tid >> 6);
    const int G = gridDim.x, bx = blockIdx.x;
    const int vcu = (G % 8 == 0) ? (bx % 8) * (G / 8) + bx / 8 : bx;
    const int gw = vcu * 8 + wave, NGW = G * 8;
    const int gt = bx * 512 + tid, GT = G * 512;
    if (tid == 0) { LAS unsigned long long* ap = (LAS unsigned long long*)(lds + ARGS_OFF);
        ap[0] = (unsigned long long)args.in[0];
        ap[1] = (unsigned long long)args.in[1];
        ap[2] = (unsigned long long)args.in[2];
        ap[3] = (unsigned long long)args.in[3];
        ap[4] = (unsigned long long)args.in[4];
        ap[5] = (unsigned long long)args.in[5];
        ap[6] = (unsigned long long)args.in[6];
        ap[7] = (unsigned long long)args.in[7];
        ap[8] = (unsigned long long)args.in[8];
        ap[9] = (unsigned long long)args.in[9];
        ap[10] = (unsigned long long)args.in[10];
        ap[11] = (unsigned long long)args.in[11];
        ap[12] = (unsigned long long)args.in[12];
        ap[13] = (unsigned long long)args.in[13];
        ap[14] = (unsigned long long)args.in[14];
        ap[15] = (unsigned long long)args.in[15];
        ap[16] = (unsigned long long)args.in[16];
        ap[17] = (unsigned long long)args.in[17];
        ap[18] = (unsigned long long)args.in[18];
        ap[19] = (unsigned long long)args.in[19];
        ap[20] = (unsigned long long)args.in[20];
        ap[21] = (unsigned long long)args.in[21];
        ap[22] = (unsigned long long)args.in[22];
        ap[23] = (unsigned long long)args.in[23];
        ap[24] = (unsigned long long)args.outp; ap[25] = (unsigned long long)args.wsp;
        ((LAS unsigned*)(lds + MISC_OFF))[0] = 0u; ((LAS unsigned*)(lds + MISC_OFF))[1] = 0u; }
    __syncthreads();
    { XcdBarrier b0_ = xcd_barrier_post(ctl + CW_BAR, (volatile LAS unsigned*)(lds + MISC_OFF)); (void)b0_; }
#define GRID_BAR() do { XcdBarrier b_; b_.bar = ctl + CW_BAR; b_.x = xb_xcc_id(); b_.st = (volatile LAS unsigned*)(lds + MISC_OFF); xcd_barrier(b_); } while (0)

#if PH0
    if (bx == G - 1) {
        for (int e = tid; e < 1024; e += 512) { const int pos = e >> 4, f = e & 15; const float inv = exp2f(-(float)f * (13.287712379549449f / 16.0f)); const float a = (float)pos * inv; float sn, cs; sincosf(a, &sn, &cs); rope[2 * e] = cs; rope[2 * e + 1] = sn; }
    }
    for (int j = bx; j < 128; j += G) {
        LAS float* scond = (LAS float*)lds; LAS float* red = (LAS float*)(lds + 73728);
        for (int e = tid; e < 9 * DM; e += 512) { const int b = e >> 11, k = e & 2047; const float v = (b < 8) ? cin[b * DM + k] : c_ctx[k]; scond[e] = v / (1.0f + expf(-v)); }
        __syncthreads();
        const int cgp = tid % 24, kl = tid / 24;
        f32x4 acc[9];
#pragma unroll
        for (int b = 0; b < 9; ++b) acc[b] = (f32x4){0.f, 0.f, 0.f, 0.f};
        if (kl < 21) {
            const float* wp = w_ada + 96 * j + 4 * cgp;
#pragma unroll 4
            for (int k = kl; k < DM; k += 21) { const f32x4 w = *(const f32x4*)(wp + (size_t)k * NMOD);
#pragma unroll
                for (int b = 0; b < 9; ++b) acc[b] += w * scond[b * DM + k]; }
#pragma unroll
            for (int b = 0; b < 9; ++b) *(LAS f32x4*)(red + (kl * 9 + b) * 96 + 4 * cgp) = acc[b];
        }
        __syncthreads();
        for (int e = tid; e < 9 * 96; e += 512) { const int b = e / 96, c = e % 96; float s = b_ada[96 * j + c];
            for (int q = 0; q < 21; ++q) s += red[(q * 9 + b) * 96 + c];
            mod[b * NMOD + 96 * j + c] = s; }
        __syncthreads();
    }
    {
        LAS float* scr = (LAS float*)(lds + wave * 8448);
        volatile LAS int* qb = (volatile LAS int*)(lds + MISC_OFF + 12);
        const int n_items = (G == 256 ? IT_TOTAL - IT_WDOWN : IT_TOTAL);
        for (int base = 0, sub = 8;;) {
            if (sub == 8) {
                __syncthreads();
                if (tid == 0) qb[0] = (int)atomicAdd(ctl, 64u);
                __syncthreads();
                base = qb[0]; sub = 0;
                if (base >= n_items) break;
            }
            const int it = base + wave * 8 + sub; ++sub;
            if (it >= n_items) continue;
            int r_ = it;
            if (r_ < IT_WIN) { const int nb = DIN / 32; transpose_item(w_in, DIN, 64 * (r_ / nb), 32 * (r_ % nb), WinT, DM, 32 * (r_ % nb), scr, lane); continue; } r_ -= IT_WIN;
            if (r_ < IT_WOUT) { const int nb = DM / 32; transpose_item(w_out, DM, 64 * (r_ / nb), 32 * (r_ % nb), WoutT, DM, 32 * (r_ % nb), scr, lane); continue; } r_ -= IT_WOUT;
            if (r_ < IT_WUP) { const int nb = NUP / 32; const int n0 = 32 * (r_ % nb); const int drow = n0 < DFF ? (n0 / 128) * 256 + (n0 % 128) : ((n0 - DFF) / 128) * 256 + 128 + ((n0 - DFF) % 128);
                transpose_item(w_up, NUP, 64 * (r_ / nb), n0, WupT, DM, drow, scr, lane); continue; } r_ -= IT_WUP;
            if (r_ < IT_WPOOL) { const int g = r_ >> 5, q = r_ & 31; transpose_item(w_pool + (size_t)g * 65536, 256, 64 * (q >> 3), 32 * (q & 7), WpoolT + (size_t)g * 65536, 256, 32 * (q & 7), scr, lane); continue; } r_ -= IT_WPOOL;
            if (r_ < IT_CV) { const int b = r_ >> 8, q = r_ & 255;
                transpose_item(cache_v + (size_t)b * PAST * DATT, DATT, 64 * (q >> 5), 32 * (q & 31), Vtl + (size_t)b * DATT * TALL, TALL, 32 * (q & 31), scr, lane); continue; } r_ -= IT_CV;
            if (r_ >= IT_CK) { r_ -= IT_CK; const int nb = DM / 32; transpose_item(w_down, DM, 64 * (r_ / nb), 32 * (r_ % nb), WdownT, DFF, 32 * (r_ % nb), scr, lane); continue; }
            { const int b = r_ >> 9, key = r_ & 511; const f32x4* src = (const f32x4*)(cache_k + ((size_t)b * PAST + key) * DATT); bf16* dst = Kl + ((size_t)b * TALL + key) * DATT;
#pragma unroll
              for (int j = 0; j < 4; ++j) *(u32x2*)(dst + 4 * lane + 256 * j) = pack4(src[lane + 64 * j]); }
        }
    }
#endif
    grid.sync();
#if PH1
    for (int row = gw; row < MROWS; row += NGW) {
        const float* xr = row < NCTX ? x_prompt + (size_t)row * DM : x_sample + (size_t)(row - NCTX) * DM; const int bidx = row < NCTX ? 8 : (row - NCTX) >> 11;
        norm_row(xr, norm1_g, mod + (size_t)bidx * NMOD + DM, mod + (size_t)bidx * NMOD, Hb + (size_t)row * DM, nullptr, lane);
    }
#endif
    GRID_BAR();
#if PH2
    {
        pg8::Gemm g{Hb, WinT, DM, DM, DM, 0}; pg8::StaticOrder S; S.init(MROWS, DIN, G, bx);
        pg8::EpiInProj E{Qb, Kc, Kl, Vtc, Vtl, Pb, state_k, state_v, rope};
        pg8::gemm_phase<pg8::EpiInProj, pg8::StaticOrder, true, true>(lds, g, S, E);
    }
#endif
    GRID_BAR();
#if PH3
    for (int item = gt; item < (MROWS / 8) * 128; item += GT) {
        const int g = (item >> 6) & 3, rb8 = (item >> 8) * 2 + ((item >> 5) & 1), c8 = g * 32 + (item & 31);
        const int row0 = rb8 * 8;
        const int T = row0 < NCTX ? TCTX : TLAT, t0 = row0 < NCTX ? (row0 & (TCTX - 1)) : ((row0 - NCTX) & (TLAT - 1));
        const bf16* base = Pb + (size_t)(row0 - t0) * DATT + c8 * 8; bf16* obase = Pooled + (size_t)(row0 - t0) * DATT + c8 * 8;
        if (g == 0) pool_item<1>(base, obase, t0, T); else if (g == 1) pool_item<2>(base, obase, t0, T); else if (g == 2) pool_item<4>(base, obase, t0, T); else pool_item<8>(base, obase, t0, T);
    }
    {
        const float s1 = wave_sum(lam_q1[lane] * lam_k1[lane]), s2 = wave_sum(lam_q2[lane] * lam_k2[lane]);
        const float lam = expf(s1) - expf(s2) + 0.2f;
        const int per = (1024 + G - 1) / G;
        for (int i = 0; i < per; ++i) { const int idx = vcu * per + i; if (idx >= 1024) break;
            const int b = idx >> 7, h = (idx >> 4) & 7, qb = idx & 15; const size_t qrow0 = (size_t)NCTX + (size_t)b * TLAT + qb * 128;
            att::unit(lds, Qb + qrow0 * DATT + h * 128, Kl + (size_t)b * TALL * DATT + h * 128, Vtl + (size_t)(b * 8 + h) * 128 * TALL, TALL, TALL / 64, AM + qrow0 * DM + h * 128, lam, subln_g); }
        for (int idx = vcu; idx < 256; idx += G) {
            const int b = idx >> 4, h = (idx >> 1) & 7, qb = idx & 1; const size_t qrow0 = (size_t)b * TCTX + qb * 128;
            att::unit(lds, Qb + qrow0 * DATT + h * 128, Kc + (size_t)b * TCTX * DATT + h * 128, Vtc + (size_t)(b * 8 + h) * 128 * TCTX, TCTX, TCTX / 64, AM + qrow0 * DM + h * 128, lam, subln_g); }
    }
#endif
    GRID_BAR();
#if PH3B
    {
        int kp = 256; asm volatile("" : "+s"(kp));
        pg8::Gemm g{Pooled, WpoolT, DATT, 256, kp, 256}; pg8::StaticOrder S; S.init(MROWS, DATT, G, bx);
        pg8::EpiPool E{AM, pool_scale};
        pg8::gemm_phase<pg8::EpiPool, pg8::StaticOrder, true, true>(lds, g, S, E);
    }
#endif
    GRID_BAR();
#if PH4
    {
        pg8::Gemm g{AM, WoutT, DM, DM, DM, 0}; pg8::PanelOrder S; S.init(MROWS, DM, G, bx);
        pg8::EpiGateBf16 E{Hb, mod + 2 * DM};
        MidBar MB{lds, S.fast ? 1 : -1};
        pg8::gemm_phase<pg8::EpiGateBf16, pg8::PanelOrder, true, true, MidBar>(lds, g, S, E, MB);
#define P5_ROW(row) { const int bidx = (row) < NCTX ? 8 : ((row) - NCTX) >> 11; const float* xr = (row) < NCTX ? x_prompt + (size_t)(row) * DM : x_sample + (size_t)((row) - NCTX) * DM; \
        norm_row(xr, norm2_g, mod + (size_t)bidx * NMOD + 4 * DM, mod + (size_t)bidx * NMOD + 3 * DM, AM + (size_t)(row) * DM, nullptr, lane, Hb + (size_t)(row) * DM, nullptr); }
        if (S.fast && bx >= 128) {
            for (int row = (bx - 128) * 8 + wave; row < 64 * 256; row += 1024) P5_ROW(row)
        }
    }
#endif
    GRID_BAR();
#if PH5
    for (int row = (G == 256 ? 64 * 256 : 0) + gw; row < MROWS; row += NGW) P5_ROW(row)
#undef P5_ROW
#endif
    GRID_BAR();
#if PH6
    {
        pg8::Gemm g{AM, WupT, DM, DM, DM, 0}; pg8::StaticOrder S; S.init(MROWS, NUP, G, bx);
        pg8::EpiUp E{ACT, ebuf, conv_k, conv_b, (LAS float*)(lds + XL_OFF)};
        pg8::gemm_phase<pg8::EpiUp, pg8::StaticOrder, true, true>(lds, g, S, E);
        if (gridDim.x == 256 && blockIdx.x >= 112) {
            int t_ = threadIdx.x; asm volatile("" : "+v"(t_));
            const int ln_ = t_ & 63, wv_ = __builtin_amdgcn_readfirstlane(t_ >> 6);
            LAS float* scr = (LAS float*)(lds + wv_ * 8448);
            for (int it = ((int)blockIdx.x - 112) * 8 + wv_; it < IT_WDOWN; it += 144 * 8) transpose_item(w_down, DM, 64 * (it >> 6), 32 * (it & 63), WdownT, DFF, 32 * (it & 63), scr, ln_);
        }
    }
#endif
    GRID_BAR();
#if PH7
    for (int item = gt; item < 56 * DFF; item += GT) {
        const int bnd = item / DFF, j = item % DFF; const int pmA = 16 + (bnd / 7) * 8 + (bnd % 7), pmB = pmA + 1;
        const int tcg = (j >> 7) * 256 + (j & 127), tcv = tcg + 128;
        const float* eA = ebuf + (size_t)pmA * 4 * NUP; const float* eB = ebuf + (size_t)pmB * 4 * NUP;
        const float g254 = eA[2 * NUP + tcg], g255 = eA[3 * NUP + tcg], g0 = eB[tcg], g1 = eB[NUP + tcg];
        const float v254 = eA[2 * NUP + tcv], v255 = eA[3 * NUP + tcv], v0 = eB[tcv], v1 = eB[NUP + tcv];
        const float k0g = conv_k[j], k1g = conv_k[NUP + j], k2g = conv_k[2 * NUP + j], bg = conv_b[j];
        const float k0v = conv_k[DFF + j], k1v = conv_k[NUP + DFF + j], k2v = conv_k[2 * NUP + DFF + j], bv = conv_b[DFF + j];
        const float ga = k0g * g254 + k1g * g255 + k2g * g0 + bg, va = k0v * v254 + k1v * v255 + k2v * v0 + bv;
        const float gb = k0g * g255 + k1g * g0 + k2g * g1 + bg, vb = k0v * v255 + k1v * v0 + k2v * v1 + bv;
        ACT[((size_t)pmA * 256 + 255) * DFF + j] = pg8::bf1(ga / (1.0f + __expf(-ga)) * va);
        ACT[((size_t)pmB * 256) * DFF + j] = pg8::bf1(gb / (1.0f + __expf(-gb)) * vb);
    }
#endif
    GRID_BAR();
#if PH8
    {
        pg8::Gemm g{ACT, WdownT, DFF, DFF, DFF, 0}; pg8::PanelOrder S; S.init(MROWS, DM, G, bx);
        pg8::EpiGateBf16 E{AM, mod + 5 * DM};
        MidBar MB{lds, S.fast ? 1 : -1};
        pg8::gemm_phase<pg8::EpiGateBf16, pg8::PanelOrder, true, true, MidBar>(lds, g, S, E, MB);
#define P9_ROW(row) { const float* xr = (row) < NCTX ? x_prompt + (size_t)(row) * DM : x_sample + (size_t)((row) - NCTX) * DM; \
        norm_row(xr, norm_f_g, nullptr, nullptr, nullptr, out + (size_t)(row) * DM, lane, Hb + (size_t)(row) * DM, AM + (size_t)(row) * DM); }
        if (S.fast && bx >= 128) {
            for (int row = (bx - 128) * 8 + wave; row < 64 * 256; row += 1024) P9_ROW(row)
        }
    }
#endif
    GRID_BAR();
#if PH9
    for (int row = (G == 256 ? 64 * 256 : 0) + gw; row < MROWS; row += NGW) P9_ROW(row)
#undef P9_ROW
#endif

}

#undef x_prompt
#undef x_sample
#undef cin
#undef cache_k
#undef cache_v
#undef c_ctx
#undef w_ada
#undef b_ada
#undef norm1_g
#undef w_in
#undef lam_q1
#undef lam_k1
#undef lam_q2
#undef lam_k2
#undef subln_g
#undef w_pool
#undef pool_scale
#undef w_out
#undef norm2_g
#undef w_up
#undef conv_k
#undef conv_b
#undef w_down
#undef norm_f_g
#undef out
#undef ws
#undef state_k
#undef state_v
#undef ctl
#undef mod
#undef rope
#undef WinT
#undef WoutT
#undef WupT
#undef WdownT
#undef WpoolT
#undef Hb
#undef Qb
#undef Kc
#undef Kl
#undef Vtc
#undef Vtl
#undef Pb
#undef Pooled
#undef AM
#undef ACT
#undef ebuf
extern "C" void kernel_launch(void* const* d_in, const int* in_sizes, int n_in, void* d_out, int out_size, void* d_ws, size_t ws_size, hipStream_t stream) {
    static int grid = 0;
    if (grid == 0) {
        if (n_in != 24 || ws_size < WS_END) { fprintf(stderr, "kernel_launch: unexpected n_in %d / ws_size %zu\n", n_in, ws_size); grid = -1; return; }
        int dev = 0, cus = 0, per_cu = 0;
        (void)hipGetDevice(&dev); (void)hipDeviceGetAttribute(&cus, hipDeviceAttributeMultiprocessorCount, dev);
        (void)hipFuncSetAttribute((const void*)fwd_kernel, hipFuncAttributeMaxDynamicSharedMemorySize, LDS_BYTES);
        (void)hipOccupancyMaxActiveBlocksPerMultiprocessor(&per_cu, (const void*)fwd_kernel, 512, LDS_BYTES);
        if (per_cu < 1) { fprintf(stderr, "kernel_launch: occupancy query returned %d\n", per_cu); per_cu = 1; }
        (void)hipGetLastError();
        grid = cus * 1;
    }
    if (grid < 0) return;
    (void)hipMemsetAsync((char*)d_ws + WS_CTL, 0, CTL_ZERO_BYTES, stream);
    Args a{};
    for (int i = 0; i < 24; ++i) a.in[i] = (const float*)d_in[i];
    a.outp = (float*)d_out; a.wsp = (unsigned char*)d_ws;
    void* kargs[] = {&a};
    hipError_t e = hipLaunchCooperativeKernel((const void*)fwd_kernel, dim3(grid), dim3(512), kargs, LDS_BYTES, stream);
    if (e != hipSuccess) fprintf(stderr, "kernel_launch: cooperative launch failed: %s (grid %d)\n", hipGetErrorString(e), grid);
}
```

```cpp
#include <hip/hip_runtime.h>
#include <hip/hip_cooperative_groups.h>
#include <cstdio>
#include <cstdint>
namespace cg = cooperative_groups;
#ifndef PH0
#define PH0 1
#endif
#ifndef PH1
#define PH1 1
#endif
#ifndef PH2
#define PH2 1
#endif
#ifndef PH3
#define PH3 1
#endif
#ifndef PH3B
#define PH3B 1
#endif
#ifndef PH4
#define PH4 1
#endif
#ifndef PH5
#define PH5 1
#endif
#ifndef PH6
#define PH6 1
#endif
#ifndef PH7
#define PH7 1
#endif
#ifndef PH8
#define PH8 1
#endif
#ifndef PH9
#define PH9 1
#endif

constexpr int DM = 2048, NCTX = 4096, NLAT = 16384, MROWS = 20480, DIN = 4096, DFF = 5504, NUP = 11008, DATT = 1024;
constexpr int TCTX = 256, TLAT = 2048, PAST = 512, TALL = 2560, NMOD = 12288;
constexpr float EPS = 1e-6f;
constexpr float QSCALE = 0.125f * 1.4426950408889634f;
namespace pg8 {
#define PG8_LAS __attribute__((address_space(3)))
typedef unsigned short bf16_t;
typedef short bf16x8 __attribute__((ext_vector_type(8)));
typedef float f32x4 __attribute__((ext_vector_type(4)));
typedef unsigned u32x4 __attribute__((ext_vector_type(4)));
constexpr int BM = 256, BK = 64, HALF = 128, HTB = HALF * BK * 2  , STAGE_BYTES = 8 * HTB, NXCD = 8, WGM = 4;

__host__ __device__ __forceinline__ int lds_byte(int r, int c) { const int st = (r >> 4) * 2 + (c >> 5), rr = r & 15, cc = c & 31, ob = rr * 64 + cc * 2; return st * 1024 + (ob ^ (((ob >> 9) & 1) << 5)); }
__host__ __device__ __forceinline__ void stage_rc(int b, int& R, int& C) { const int st = b / 1024, sb = b % 1024, swz = sb ^ (((sb >> 9) & 1) << 5); R = (st >> 1) * 16 + swz / 64; C = (st & 1) * 32 + (swz % 64) / 2; }
__host__ __device__ __forceinline__ int perm32(int rho) { const int n = rho >> 4, i = rho & 15; return 8 * (i >> 2) + 4 * n + (i & 3); }

struct Unit { int pm, pn; };
struct Gemm { const bf16_t* A; const bf16_t* Bt; int lda, ldb, K, acol; };

struct StaticOrder {
    int nM, nN, nwg, G, c;
    __host__ __device__ void init(int M, int N, int G_, int c_) { nM = M / BM; nN = N / BM; nwg = nM * nN; G = G_; c = c_; }
    __host__ __device__ bool next(int i, Unit& u) const {
        const long L = (long)i * G + c; if (L >= nwg) return false;
        int wgid = (int)L; { const int q = nwg / NXCD, r = nwg % NXCD, xcd = wgid % NXCD, off = wgid / NXCD; wgid = (xcd < r ? xcd * (q + 1) : r * (q + 1) + (xcd - r) * q) + off; }
        const int nig = WGM * nN, gid = wgid / nig, fm = gid * WGM, gsz = (nM - fm) < WGM ? (nM - fm) : WGM;
        u.pm = fm + ((wgid % nig) % gsz); u.pn = (wgid % nig) / gsz; return true;
    }
    __device__ __forceinline__ void a_ready(const Unit&) const {}
    __device__ __forceinline__ void done(const Unit&) const {}
};

struct PanelOrder {
    StaticOrder so; bool fast;
    __host__ __device__ void init(int M, int N, int G_, int c_) { so.init(M, N, G_, c_); fast = (G_ == 256 && so.nN == 8 && so.nM == 80); }
    __host__ __device__ bool next(int i, Unit& u) const {
        if (!fast) return so.next(i, u);
        const int c = so.c, xcd = c & 7, j = c >> 3;
        if (i < 2) { u.pm = i * 32 + xcd * 4 + (j & 3); u.pn = j >> 2; return true; }
        if (i == 2 && c < 128) { u.pm = 64 + xcd * 2 + (j & 1); u.pn = j >> 1; return true; }
        return false;
    }
    __device__ __forceinline__ void a_ready(const Unit&) const {}
    __device__ __forceinline__ void done(const Unit&) const {}
};

struct NoMid { __device__ __forceinline__ void operator()(int) const {} };
template <class Epi, class Sched, bool ALIGN_EPI = false, bool SP2 = false, class Mid = NoMid>
__device__ __forceinline__ void gemm_phase(PG8_LAS unsigned char* lds, const Gemm g, const Sched& S, const Epi& E, const Mid& MH = Mid()) {
    int tid_ = threadIdx.x; asm volatile("" : "+v"(tid_));
    const int tid = tid_, wid = __builtin_amdgcn_readfirstlane(tid >> 6), lane = tid & 63, wr = wid >> 2, wc = wid & 3, fr = lane & 15, fq = lane >> 4;
    const int K = g.K, nt = K / BK;
    unsigned voffA[2], voffB[2];
#pragma unroll
    for (int i = 0; i < 2; ++i) { int R, C; stage_rc(tid * 16 + i * 8192, R, C); const int Rb = Epi::PERM ? ((R & ~31) + perm32(R & 31)) : R;
        voffA[i] = (unsigned)(R * g.lda + C) * 2u; voffB[i] = (unsigned)(Rb * g.ldb + C) * 2u; }
    const size_t kstep = (size_t)(BK * 2);
    const size_t hstepA = (size_t)HALF * g.lda * 2, hstepB = (size_t)HALF * g.ldb * 2;
    const size_t tstepA = 2 * hstepA, tstepB = 2 * hstepB, acolb = (size_t)g.acol * 2;
    const unsigned ldsw = (unsigned)wid * 1024u;
    const int aoff = lds_byte(wr * 64 + fr, fq * 8), boff = lds_byte(wc * 32 + fr, fq * 8);
#define PG8_SA(b, h) (((b) * 2 + (h)) * HTB)
#define PG8_SB(b, h) ((4 + (b) * 2 + (h)) * HTB)
#define PG8_STAGE(bufoff, gbase, voff) do { _Pragma("unroll") for (int _i = 0; _i < 2; ++_i) \
        __builtin_amdgcn_global_load_lds((const unsigned*)((const char*)(gbase) + (voff)[_i]), (PG8_LAS unsigned*)(lds + (bufoff) + ldsw + _i * 8192), 16, 0, 0); } while (0)
#define PG8_LDA(dst, b, h) do { _Pragma("unroll") for (int m = 0; m < 4; ++m) _Pragma("unroll") for (int k = 0; k < 2; ++k) dst[m][k] = *(const PG8_LAS bf16x8*)(lds + PG8_SA(b, h) + aoff + m * 2048 + k * 1024); } while (0)
#define PG8_LDB(dst, b, h) do { _Pragma("unroll") for (int n = 0; n < 2; ++n) _Pragma("unroll") for (int k = 0; k < 2; ++k) dst[n][k] = *(const PG8_LAS bf16x8*)(lds + PG8_SB(b, h) + boff + n * 2048 + k * 1024); } while (0)
#define PG8_MMA(ai, bj, At, Bt) do { __builtin_amdgcn_s_setprio(1); _Pragma("unroll") for (int m = 0; m < 4; ++m) _Pragma("unroll") for (int n = 0; n < 2; ++n) _Pragma("unroll") for (int k = 0; k < 2; ++k) \
        acc[ai][bj][m][n] = __builtin_amdgcn_mfma_f32_16x16x32_bf16(Bt[n][k], At[m][k], acc[ai][bj][m][n], 0, 0, 0); __builtin_amdgcn_s_setprio(0); } while (0)
#define PG8_WAIT_V(n) asm volatile("s_waitcnt vmcnt(" #n ")" ::: "memory")
#define PG8_WAIT_L(n) asm volatile("s_waitcnt lgkmcnt(" #n ")" ::: "memory")
#define PG8_BAR __builtin_amdgcn_s_barrier()
#define PG8_SCHED __builtin_amdgcn_sched_barrier(0)
    Unit cur, nxt; int ui = 0;
    if (!S.next(0, cur)) return;
    f32x4 acc[2][2][4][2];
#pragma unroll
    for (int a = 0; a < 2; ++a)
#pragma unroll
        for (int b = 0; b < 2; ++b)
#pragma unroll
            for (int m = 0; m < 4; ++m)
#pragma unroll
                for (int n = 0; n < 2; ++n) acc[a][b][m][n] = (f32x4){0.f, 0.f, 0.f, 0.f};
    bf16x8 At[4][2], B0[2][2], B1[2][2];
    const char* cA = (const char*)g.A + (size_t)cur.pm * tstepA + (size_t)cur.pn * acolb; const char* cB = (const char*)g.Bt + (size_t)cur.pn * tstepB;
    S.a_ready(cur);
    if constexpr (SP2) {
        PG8_STAGE(PG8_SB(0, 0), cB, voffB); PG8_STAGE(PG8_SB(0, 1), cB + hstepB, voffB); PG8_STAGE(PG8_SA(0, 0), cA, voffA); PG8_STAGE(PG8_SA(0, 1), cA + hstepA, voffA);
        if (wr == 1) PG8_BAR;
        PG8_WAIT_V(2); PG8_BAR;
        PG8_STAGE(PG8_SB(1, 0), cB + kstep, voffB); PG8_STAGE(PG8_SA(1, 0), cA + kstep, voffA); PG8_STAGE(PG8_SB(1, 1), cB + hstepB + kstep, voffB);
        PG8_WAIT_V(6); PG8_BAR;
    } else {
        PG8_STAGE(PG8_SB(0, 0), cB, voffB); PG8_STAGE(PG8_SA(0, 0), cA, voffA); PG8_STAGE(PG8_SB(0, 1), cB + hstepB, voffB); PG8_STAGE(PG8_SA(0, 1), cA + hstepA, voffA);
        if (wr == 1) PG8_BAR;
        PG8_WAIT_V(4); PG8_BAR;
        PG8_STAGE(PG8_SB(1, 0), cB + kstep, voffB); PG8_STAGE(PG8_SA(1, 0), cA + kstep, voffA); PG8_STAGE(PG8_SB(1, 1), cB + hstepB + kstep, voffB);
        PG8_WAIT_V(6); PG8_BAR;
    }
    for (;;) {
        const bool has_next = S.next(ui + 1, nxt);
        const char* nA = has_next ? (const char*)g.A + (size_t)nxt.pm * tstepA + (size_t)nxt.pn * acolb : cA; const char* nB = has_next ? (const char*)g.Bt + (size_t)nxt.pn * tstepB : cB;
        for (int t = 0; t < nt; t += 2) {
            const bool last = (t == nt - 2);
            const char* a1 = cA + (size_t)(t + 1) * kstep;
            const char* a2 = last ? nA : cA + (size_t)(t + 2) * kstep; const char* b2 = last ? nB : cB + (size_t)(t + 2) * kstep;
            const char* a3 = a2 + kstep; const char* b3 = b2 + kstep;
            if (last && has_next) S.a_ready(nxt);
            if constexpr (SP2) {
            PG8_LDB(B0, 0, 0); PG8_LDB(B1, 0, 1); PG8_SCHED; PG8_LDA(At, 0, 0); PG8_STAGE(PG8_SA(1, 1), a1 + hstepA, voffA);
            PG8_WAIT_V(8); PG8_WAIT_L(0); PG8_BAR; PG8_MMA(0, 0, At, B0); PG8_MMA(0, 1, At, B1); PG8_BAR; PG8_SCHED;
            PG8_LDA(At, 0, 1); PG8_STAGE(PG8_SB(0, 0), b2, voffB); PG8_STAGE(PG8_SB(0, 1), b2 + hstepB, voffB); PG8_STAGE(PG8_SA(0, 0), a2, voffA);
            PG8_WAIT_V(8); PG8_WAIT_L(0); PG8_BAR; PG8_MMA(1, 0, At, B0); PG8_MMA(1, 1, At, B1); PG8_BAR; PG8_SCHED;
            PG8_LDB(B0, 1, 0); PG8_LDB(B1, 1, 1); PG8_SCHED; PG8_LDA(At, 1, 0); PG8_STAGE(PG8_SA(0, 1), a2 + hstepA, voffA);
            PG8_WAIT_V(8); PG8_WAIT_L(0); PG8_BAR; PG8_MMA(0, 0, At, B0); PG8_MMA(0, 1, At, B1); PG8_BAR; PG8_SCHED;
            PG8_LDA(At, 1, 1); PG8_STAGE(PG8_SB(1, 0), b3, voffB); PG8_STAGE(PG8_SB(1, 1), b3 + hstepB, voffB); PG8_STAGE(PG8_SA(1, 0), a3, voffA);
            PG8_WAIT_V(8); PG8_WAIT_L(0); PG8_BAR; PG8_MMA(1, 0, At, B0); PG8_MMA(1, 1, At, B1); PG8_BAR; PG8_SCHED;
            } else {
            PG8_LDB(B0, 0, 0); PG8_SCHED; PG8_LDA(At, 0, 0); PG8_STAGE(PG8_SA(1, 1), a1 + hstepA, voffA);
            PG8_WAIT_L(8); PG8_BAR; PG8_WAIT_L(0); PG8_MMA(0, 0, At, B0); PG8_BAR; PG8_SCHED;
            PG8_LDB(B1, 0, 1); PG8_STAGE(PG8_SB(0, 0), b2, voffB);
            PG8_BAR; PG8_WAIT_L(0); PG8_MMA(0, 1, At, B1); PG8_BAR;
            PG8_LDA(At, 0, 1); PG8_STAGE(PG8_SA(0, 0), a2, voffA);
            PG8_BAR; PG8_WAIT_L(0); PG8_MMA(1, 0, At, B0); PG8_BAR; PG8_SCHED;
            PG8_STAGE(PG8_SB(0, 1), b2 + hstepB, voffB);
            PG8_WAIT_V(6); PG8_BAR; PG8_MMA(1, 1, At, B1); PG8_BAR;
            PG8_LDB(B0, 1, 0); PG8_SCHED; PG8_LDA(At, 1, 0); PG8_STAGE(PG8_SA(0, 1), a2 + hstepA, voffA);
            PG8_WAIT_L(8); PG8_BAR; PG8_WAIT_L(0); PG8_MMA(0, 0, At, B0); PG8_BAR; PG8_SCHED;
            PG8_LDB(B1, 1, 1); PG8_STAGE(PG8_SB(1, 0), b3, voffB);
            PG8_BAR; PG8_WAIT_L(0); PG8_MMA(0, 1, At, B1); PG8_BAR;
            PG8_LDA(At, 1, 1); PG8_STAGE(PG8_SA(1, 0), a3, voffA);
            PG8_BAR; PG8_WAIT_L(0); PG8_MMA(1, 0, At, B0); PG8_BAR; PG8_SCHED;
            PG8_STAGE(PG8_SB(1, 1), b3 + hstepB, voffB);
            PG8_WAIT_V(6); PG8_BAR; PG8_MMA(1, 1, At, B1); PG8_BAR;
            }
        }
        if constexpr (ALIGN_EPI) { if (wr == 0) PG8_BAR; }
        if constexpr (!Epi::AFTER_DRAIN) { E(acc, cur, wr, wc, fr, fq); S.done(cur); }
        MH(ui);
        if (!has_next) break;
#pragma unroll
        for (int a = 0; a < 2; ++a)
#pragma unroll
            for (int b = 0; b < 2; ++b)
#pragma unroll
                for (int m = 0; m < 4; ++m)
#pragma unroll
                    for (int n = 0; n < 2; ++n) acc[a][b][m][n] = (f32x4){0.f, 0.f, 0.f, 0.f};
        cur = nxt; cA = nA; cB = nB; ++ui;
        if constexpr (ALIGN_EPI) { if (wr == 1) PG8_BAR; }
    }
    PG8_WAIT_V(0);
    if constexpr (!ALIGN_EPI) { if (wr == 0) PG8_BAR; }
    PG8_BAR;
    if constexpr (Epi::AFTER_DRAIN) { E.fused(acc, cur, wr, wc, fr, fq, lds, wid, lane); S.done(cur); }
#undef PG8_SA
#undef PG8_SB
#undef PG8_STAGE
#undef PG8_LDA
#undef PG8_LDB
#undef PG8_MMA
#undef PG8_WAIT_V
#undef PG8_WAIT_L
#undef PG8_BAR
#undef PG8_SCHED
}
typedef float f32x2 __attribute__((ext_vector_type(2)));
typedef __bf16 bf16x2_t __attribute__((ext_vector_type(2)));
typedef unsigned u32x2 __attribute__((ext_vector_type(2)));
__device__ __forceinline__ unsigned cvtpk(float lo, float hi) { f32x2 v = {lo, hi}; bf16x2_t b = __builtin_convertvector(v, bf16x2_t); return __builtin_bit_cast(unsigned, b); }
__device__ __forceinline__ u32x2 pack4(f32x4 v) { u32x2 w; w.x = cvtpk(v[0], v[1]); w.y = cvtpk(v[2], v[3]); return w; }
__device__ __forceinline__ unsigned short bf1(float v) { return (unsigned short)(cvtpk(v, 0.f) & 0xffffu); }

struct EpiInProj {
    static constexpr bool PERM = false, AFTER_DRAIN = false;
    bf16_t *Q, *Kc, *Kl, *Vtc, *Vtl, *P; float *sk, *sv; const float* rope;
    __device__ __forceinline__ void operator()(const f32x4 (&acc)[2][2][4][2], const Unit& u, int wr, int wc, int fr, int fq) const {
        const int kind = u.pn >> 2; const bool lat = u.pm >= 16; const int pml = u.pm - 16;
        const int b = lat ? (pml >> 3) : u.pm; const int t0 = lat ? (pml & 7) * 256 : 0; const int cb = (u.pn & 3) * 256;
#pragma unroll
        for (int ai = 0; ai < 2; ++ai)
#pragma unroll
            for (int m = 0; m < 4; ++m) {
                const int tl = ai * HALF + wr * 64 + m * 16 + fr; const int t = t0 + tl; const size_t row = (size_t)u.pm * BM + tl;
                f32x4 c0v = {1.f, 1.f, 1.f, 1.f}, s0v = {0.f, 0.f, 0.f, 0.f};
                if (kind <= 1 && lat) { const int pos = (wc & 1) ? (t & 63) : (t >> 6); const f32x4* rp = (const f32x4*)(rope + (pos * 16 + fq * 4) * 2);
                    const f32x4 a = rp[0], bq = rp[1]; c0v = (f32x4){a[0], a[2], bq[0], bq[2]}; s0v = (f32x4){a[1], a[3], bq[1], bq[3]}; }
#pragma unroll
                for (int bj = 0; bj < 2; ++bj) {
                    f32x4 v0 = acc[ai][bj][m][0], v1 = acc[ai][bj][m][1];
                    const int c0 = cb + bj * HALF + wc * 32 + fq * 4;
                    if (kind <= 1 && lat) { const f32x4 r0 = v0 * c0v - v1 * s0v, r1 = v1 * c0v + v0 * s0v; v0 = r0; v1 = r1; }
                    if (kind == 0) { v0 = v0 * QSCALE; v1 = v1 * QSCALE; bf16_t* o = Q + row * DATT + c0; *(u32x2*)o = pack4(v0); *(u32x2*)(o + 16) = pack4(v1); }
                    else if (kind == 1) {
                        if (!lat) { float* so = sk + row * DATT + c0; *(f32x4*)so = v0; *(f32x4*)(so + 16) = v1; bf16_t* o = Kc + row * DATT + c0; *(u32x2*)o = pack4(v0); *(u32x2*)(o + 16) = pack4(v1); }
                        else { bf16_t* o = Kl + ((size_t)b * TALL + PAST + t) * DATT + c0; *(u32x2*)o = pack4(v0); *(u32x2*)(o + 16) = pack4(v1); }
                    } else if (kind == 2) {
                        const int head = (u.pn & 3) * 2 + bj, dcol = wc * 32 + fq * 4;
                        if (!lat) { float* so = sv + row * DATT + c0; *(f32x4*)so = v0; *(f32x4*)(so + 16) = v1;
                            bf16_t* o = Vtc + ((size_t)(b * 8 + head) * 128 + dcol) * TCTX + t;
#pragma unroll
                            for (int i = 0; i < 4; ++i) { o[(size_t)i * TCTX] = bf1(v0[i]); o[(size_t)(i + 16) * TCTX] = bf1(v1[i]); } }
                        else { bf16_t* o = Vtl + ((size_t)(b * 8 + head) * 128 + dcol) * TALL + PAST + t;
#pragma unroll
                            for (int i = 0; i < 4; ++i) { o[(size_t)i * TALL] = bf1(v0[i]); o[(size_t)(i + 16) * TALL] = bf1(v1[i]); } }
                    } else { bf16_t* o = P + row * DATT + c0; *(u32x2*)o = pack4(v0); *(u32x2*)(o + 16) = pack4(v1); }
                }
            }
    }
};
struct EpiResid {
    static constexpr bool PERM = false, AFTER_DRAIN = false;
    const float *xa, *xb; float* out; const float* gate;
    __device__ __forceinline__ void operator()(const f32x4 (&acc)[2][2][4][2], const Unit& u, int wr, int wc, int fr, int fq) const {
        const int bidx = u.pm < 16 ? 8 : ((u.pm - 16) >> 3);
        const float* gp = gate + (size_t)bidx * NMOD + u.pn * BM + wc * 32 + fq * 4;
        f32x4 gv[2][2];
#pragma unroll
        for (int bj = 0; bj < 2; ++bj)
#pragma unroll
            for (int n = 0; n < 2; ++n) gv[bj][n] = *(const f32x4*)(gp + bj * HALF + n * 16);
#pragma unroll
        for (int ai = 0; ai < 2; ++ai)
#pragma unroll
            for (int m = 0; m < 4; ++m) {
                const size_t row = (size_t)u.pm * BM + ai * HALF + wr * 64 + m * 16 + fr;
                const float* xr = (row < (size_t)NCTX ? xa + row * DM : xb + (row - NCTX) * DM) + u.pn * BM + wc * 32 + fq * 4;
                float* orow = out + row * DM + u.pn * BM + wc * 32 + fq * 4;
#pragma unroll
                for (int bj = 0; bj < 2; ++bj)
#pragma unroll
                    for (int n = 0; n < 2; ++n) { const f32x4 xv = *(const f32x4*)(xr + bj * HALF + n * 16); *(f32x4*)(orow + bj * HALF + n * 16) = xv + gv[bj][n] * acc[ai][bj][m][n]; }
            }
    }
};
struct EpiGateBf16 {
    static constexpr bool PERM = false, AFTER_DRAIN = false;
    bf16_t* dst; const float* gate;
    __device__ __forceinline__ void operator()(const f32x4 (&acc)[2][2][4][2], const Unit& u, int wr, int wc, int fr, int fq) const {
        const int bidx = u.pm < 16 ? 8 : ((u.pm - 16) >> 3);
        const int cofs = u.pn * BM + wc * 32 + fq * 4;
        const float* gp = gate + (size_t)bidx * NMOD + cofs;
        bf16_t* o0 = dst + ((size_t)u.pm * BM + wr * 64 + fr) * DM + cofs;
#pragma unroll
        for (int bj = 0; bj < 2; ++bj)
#pragma unroll
            for (int n = 0; n < 2; ++n) {
                const f32x4 gv = *(const f32x4*)(gp + bj * HALF + n * 16);
#pragma unroll
                for (int ai = 0; ai < 2; ++ai)
#pragma unroll
                    for (int m = 0; m < 4; ++m) *(u32x2*)(o0 + (size_t)(ai * HALF + m * 16) * DM + bj * HALF + n * 16) = pack4(acc[ai][bj][m][n] * gv);
            }
    }
};
struct EpiPool {
    static constexpr bool PERM = false, AFTER_DRAIN = false;
    bf16_t* am; const float* scale;
    __device__ __forceinline__ void operator()(const f32x4 (&acc)[2][2][4][2], const Unit& u, int wr, int wc, int fr, int fq) const {
        const int cbase = u.pn * BM + wc * 32 + fq * 4;
        bf16_t* o0 = am + ((size_t)u.pm * BM + wr * 64 + fr) * DM + DATT + cbase;
#pragma unroll
        for (int bj = 0; bj < 2; ++bj)
#pragma unroll
            for (int n = 0; n < 2; ++n) {
                const f32x4 sv = *(const f32x4*)(scale + cbase + bj * HALF + n * 16);
#pragma unroll
                for (int ai = 0; ai < 2; ++ai)
#pragma unroll
                    for (int m = 0; m < 4; ++m) *(u32x2*)(o0 + (size_t)(ai * HALF + m * 16) * DM + bj * HALF + n * 16) = pack4(acc[ai][bj][m][n] * sv);
            }
    }
};
#define DPP_F(v, ctrl) __builtin_bit_cast(float, __builtin_amdgcn_update_dpp(0, __builtin_bit_cast(int, (v)), (ctrl), 0xf, 0xf, true))
#ifndef USE_DPP
#define USE_DPP 0
#endif
#if USE_DPP
__device__ __forceinline__ f32x4 dpp_shr1(f32x4 v)  { return (f32x4){DPP_F(v[0], 0x111), DPP_F(v[1], 0x111), DPP_F(v[2], 0x111), DPP_F(v[3], 0x111)}; }
__device__ __forceinline__ f32x4 dpp_shl1(f32x4 v)  { return (f32x4){DPP_F(v[0], 0x101), DPP_F(v[1], 0x101), DPP_F(v[2], 0x101), DPP_F(v[3], 0x101)}; }
__device__ __forceinline__ f32x4 dpp_shl15(f32x4 v) { return (f32x4){DPP_F(v[0], 0x10F), DPP_F(v[1], 0x10F), DPP_F(v[2], 0x10F), DPP_F(v[3], 0x10F)}; }
__device__ __forceinline__ f32x4 dpp_shr15(f32x4 v) { return (f32x4){DPP_F(v[0], 0x11F), DPP_F(v[1], 0x11F), DPP_F(v[2], 0x11F), DPP_F(v[3], 0x11F)}; }
#else
__device__ __forceinline__ f32x4 shfl_sel(f32x4 v, int src, bool ok) { f32x4 o;
#pragma unroll
    for (int i = 0; i < 4; ++i) { const float t = __shfl(v[i], src); o[i] = ok ? t : 0.f; } return o; }
__device__ __forceinline__ f32x4 dpp_shr1(f32x4 v)  { const int l = threadIdx.x & 63; return shfl_sel(v, l - 1, (l & 15) != 0); }
__device__ __forceinline__ f32x4 dpp_shl1(f32x4 v)  { const int l = threadIdx.x & 63; return shfl_sel(v, l + 1, (l & 15) != 15); }
__device__ __forceinline__ f32x4 dpp_shl15(f32x4 v) { const int l = threadIdx.x & 63; return shfl_sel(v, l + 15, (l & 15) == 0); }
__device__ __forceinline__ f32x4 dpp_shr15(f32x4 v) { const int l = threadIdx.x & 63; return shfl_sel(v, l - 15, (l & 15) == 15); }
#endif
__device__ __forceinline__ f32x4 silu_mul(f32x4 g, f32x4 v) {
    f32x4 o;
#pragma unroll
    for (int i = 0; i < 4; ++i) { const float e = __builtin_amdgcn_exp2f(-g[i] * 1.4426950408889634f); o[i] = g[i] * __builtin_amdgcn_rcpf(1.0f + e) * v[i]; }
    return o;
}
struct EpiUp {
    static constexpr bool PERM = false, AFTER_DRAIN = false;
    bf16_t* act; float* ebuf; const float* ck; const float* cbias; PG8_LAS float* xl;
    __device__ __forceinline__ void operator()(const f32x4 (&acc)[2][2][4][2], const Unit& u, int wr, int wc, int fr, int fq) const {
        const int colw = wc * 32 + fq * 4;
#pragma unroll
        for (int ai = 0; ai < 2; ++ai)
#pragma unroll
            for (int bj = 0; bj < 2; ++bj)
#pragma unroll
                for (int n = 0; n < 2; ++n) { const int col = bj * HALF + n * 16 + colw, rb = ai * 2 + wr;
                    if (fr == 0) *(PG8_LAS f32x4*)(xl + (rb * 2) * 256 + col) = acc[ai][bj][0][n];
                    if (fr == 15) *(PG8_LAS f32x4*)(xl + (rb * 2 + 1) * 256 + col) = acc[ai][bj][3][n]; }
        float* eb = ebuf + (size_t)u.pm * 4 * NUP + u.pn * BM + colw;
        if (wr == 0 && fr < 2) {
#pragma unroll
            for (int bj = 0; bj < 2; ++bj)
#pragma unroll
                for (int n = 0; n < 2; ++n) *(f32x4*)(eb + (size_t)fr * NUP + bj * HALF + n * 16) = acc[0][bj][0][n]; }
        if (wr == 1 && fr >= 14) {
#pragma unroll
            for (int bj = 0; bj < 2; ++bj)
#pragma unroll
                for (int n = 0; n < 2; ++n) *(f32x4*)(eb + (size_t)(fr - 12) * NUP + bj * HALF + n * 16) = acc[1][bj][3][n]; }
        asm volatile("s_waitcnt lgkmcnt(0)" ::: "memory"); __builtin_amdgcn_s_barrier(); asm volatile("" ::: "memory");
#pragma unroll
        for (int n = 0; n < 2; ++n) {
            const int gc = u.pn * HALF + n * 16 + colw;
            const f32x4 k0g = *(const f32x4*)(ck + gc), k1g = *(const f32x4*)(ck + NUP + gc), k2g = *(const f32x4*)(ck + 2 * NUP + gc), bg = *(const f32x4*)(cbias + gc);
            const f32x4 k0v = *(const f32x4*)(ck + DFF + gc), k1v = *(const f32x4*)(ck + NUP + DFF + gc), k2v = *(const f32x4*)(ck + 2 * NUP + DFF + gc), bv = *(const f32x4*)(cbias + DFF + gc);
#pragma unroll
            for (int ai = 0; ai < 2; ++ai) {
                const int rb = ai * 2 + wr; const f32x4 z4 = {0.f, 0.f, 0.f, 0.f};
                const int l_ = threadIdx.x & 63, srcR = (l_ & 48) | ((l_ - 1) & 15), srcL = (l_ & 48) | ((l_ + 1) & 15);
                int Rp[4] = {0, 0, 0, 0}, Lc[4], Ln[4] = {0, 0, 0, 0};
#pragma unroll
                for (int i = 0; i < 4; ++i) Lc[i] = __shfl((int)cvtpk(acc[ai][0][0][n][i], acc[ai][1][0][n][i]), srcL);
#pragma unroll
                for (int m = 0; m < 4; ++m) {
                    const f32x4 cg_ = acc[ai][0][m][n], cv_ = acc[ai][1][m][n];
                    int Rc[4];
#pragma unroll
                    for (int i = 0; i < 4; ++i) Rc[i] = __shfl((int)cvtpk(cg_[i], cv_[i]), srcR);
                    if (m < 3) {
#pragma unroll
                        for (int i = 0; i < 4; ++i) Ln[i] = __shfl((int)cvtpk(acc[ai][0][m < 3 ? m + 1 : 3][n][i], acc[ai][1][m < 3 ? m + 1 : 3][n][i]), srcL); }
                    f32x4 ug, uv, dg, dv;
#pragma unroll
                    for (int i = 0; i < 4; ++i) {
                        const unsigned up = (unsigned)(fr > 0 ? Rc[i] : Rp[i]), dn = (unsigned)(fr < 15 ? Lc[i] : Ln[i]);
                        ug[i] = __builtin_bit_cast(float, up << 16); uv[i] = __builtin_bit_cast(float, up & 0xffff0000u);
                        dg[i] = __builtin_bit_cast(float, dn << 16); dv[i] = __builtin_bit_cast(float, dn & 0xffff0000u);
                        Rp[i] = Rc[i]; Lc[i] = Ln[i];
                    }
                    if (m == 0 && fr == 0) { ug = z4; uv = z4; if (rb > 0) { ug = *(const PG8_LAS f32x4*)(xl + ((rb - 1) * 2 + 1) * 256 + n * 16 + colw); uv = *(const PG8_LAS f32x4*)(xl + ((rb - 1) * 2 + 1) * 256 + HALF + n * 16 + colw); } }
                    if (m == 3 && fr == 15) { dg = z4; dv = z4; if (rb < 3) { dg = *(const PG8_LAS f32x4*)(xl + ((rb + 1) * 2) * 256 + n * 16 + colw); dv = *(const PG8_LAS f32x4*)(xl + ((rb + 1) * 2) * 256 + HALF + n * 16 + colw); } }
                    const f32x4 gg = k0g * ug + k1g * cg_ + k2g * dg + bg, vv = k0v * uv + k1v * cv_ + k2v * dv + bv;
                    const size_t row = (size_t)u.pm * BM + ai * HALF + wr * 64 + m * 16 + fr;
                    *(u32x2*)(act + row * DFF + gc) = pack4(silu_mul(gg, vv));
                }
            }
        }
    }
};
}
#define LAS __attribute__((address_space(3)))
typedef unsigned short bf16;
typedef float f32x4 __attribute__((ext_vector_type(4)));
typedef float f32x16 __attribute__((ext_vector_type(16)));
typedef short bf16x8 __attribute__((ext_vector_type(8)));
typedef short s16x4 __attribute__((ext_vector_type(4)));
typedef unsigned u32x4 __attribute__((ext_vector_type(4)));
typedef unsigned u32x2 __attribute__((ext_vector_type(2)));
using pg8::cvtpk; using pg8::pack4;
__device__ __forceinline__ float wave_sum(float v) {
#pragma unroll
    for (int o = 1; o < 64; o <<= 1) v += __shfl_xor(v, o);
    return v;
}
__device__ __forceinline__ float bf_lo(unsigned w) { return __builtin_bit_cast(float, w << 16); }
__device__ __forceinline__ float bf_hi(unsigned w) { return __builtin_bit_cast(float, w & 0xffff0000u); }
__device__ __forceinline__ float half_max(float v) { return fmaxf(v, __shfl_xor(v, 32)); }
__device__ __forceinline__ float half_sum(float v) { return v + __shfl_xor(v, 32); }

constexpr size_t MiB = 1u << 20;
constexpr size_t WS_CTL = 0, CTL_ZERO_BYTES = 32768;
constexpr size_t WS_MOD = 1 * MiB, WS_ROPE = 2 * MiB;
constexpr size_t WS_WIN = 4 * MiB, WS_WOUT = 20 * MiB, WS_WUP = 28 * MiB, WS_WDOWN = 71 * MiB, WS_WPOOL = 93 * MiB;
constexpr size_t WS_H = 94 * MiB, WS_Q = 174 * MiB, WS_KC = 214 * MiB, WS_KL = 222 * MiB, WS_VTC = 262 * MiB, WS_VTL = 270 * MiB, WS_P = 310 * MiB, WS_POOLED = 350 * MiB;
constexpr size_t WS_AM = 390 * MiB, WS_EBUF = 470 * MiB, WS_ACT = 174 * MiB, WS_END = 484 * MiB;
static_assert(WS_ACT + (size_t)MROWS * DFF * 2 <= WS_AM, "act overlay");
static_assert(WS_EBUF + (size_t)80 * 4 * NUP * 4 <= WS_END, "ebuf");
constexpr int RING_BYTES = 131072, XL_OFF = RING_BYTES, LDS_BYTES = 147456;

__device__ __forceinline__ void transpose_item(const float* W, int ldw, int k0, int n0, bf16* WT, int ldt, int drow0, LAS float* scr, int lane) {
    float tv[32];
#pragma unroll
    for (int i = 0; i < 32; ++i) tv[i] = W[(size_t)(k0 + 2 * i + (lane >> 5)) * ldw + n0 + (lane & 31)];
#pragma unroll
    for (int i = 0; i < 32; ++i) scr[(2 * i + (lane >> 5)) * 33 + (lane & 31)] = tv[i];
    asm volatile("s_waitcnt lgkmcnt(0)" ::: "memory");
    const int c = lane & 7;
#pragma unroll
    for (int j = 0; j < 4; ++j) { const int n = (lane >> 3) + 8 * j; const LAS float* s = scr + (8 * c) * 33 + n;
        u32x4 o; o.x = cvtpk(s[0 * 33], s[1 * 33]); o.y = cvtpk(s[2 * 33], s[3 * 33]); o.z = cvtpk(s[4 * 33], s[5 * 33]); o.w = cvtpk(s[6 * 33], s[7 * 33]);
        *(u32x4*)(WT + (size_t)(drow0 + n) * ldt + k0 + 8 * c) = o; }
    asm volatile("s_waitcnt lgkmcnt(0)" ::: "memory");
}
constexpr int IT_WIN = (DM / 64) * (DIN / 32), IT_WOUT = (DM / 64) * (DM / 32), IT_WUP = (DM / 64) * (NUP / 32), IT_WDOWN = (DFF / 64) * (DM / 32), IT_WPOOL = 4 * 4 * 8,
              IT_CV = 8 * (PAST / 64) * (DATT / 32), IT_CK = 8 * PAST;
constexpr int IT_TOTAL = IT_WIN + IT_WUP + IT_WPOOL + IT_CV + IT_CK + IT_WOUT + IT_WDOWN;

struct Args { const float* in[24]; float* outp; unsigned char* wsp; };

__device__ __forceinline__ void norm_row(const float* xrow, const float* g, const float* sc, const float* sh, bf16* outb, float* outf, int lane, const bf16* addb = nullptr, const bf16* addc = nullptr) {
    const f32x4* xr = (const f32x4*)xrow + lane;
    f32x4 v[8]; float s = 0.f;
#pragma unroll
    for (int j = 0; j < 8; ++j) { v[j] = xr[64 * j];
        if (addb) { const u32x2 d_ = ((const u32x2*)addb + lane)[64 * j]; v[j] += (f32x4){bf_lo(d_.x), bf_hi(d_.x), bf_lo(d_.y), bf_hi(d_.y)}; }
        if (addc) { const u32x2 d_ = ((const u32x2*)addc + lane)[64 * j]; v[j] += (f32x4){bf_lo(d_.x), bf_hi(d_.x), bf_lo(d_.y), bf_hi(d_.y)}; }
        s += (v[j].x * v[j].x + v[j].y * v[j].y) + (v[j].z * v[j].z + v[j].w * v[j].w); }
    const float rstd = 1.0f / sqrtf(wave_sum(s) * (1.0f / DM) + EPS);
#pragma unroll
    for (int j = 0; j < 8; ++j) {
        const int c = 4 * lane + 256 * j;
        f32x4 y = v[j] * rstd * *(const f32x4*)(g + c);
        if (sc) y = y * (1.0f + *(const f32x4*)(sc + c)) + *(const f32x4*)(sh + c);
        if (outb) *(u32x2*)(outb + c) = pack4(y); else *(f32x4*)(outf + c) = y;
    }
}

template <int HW> __device__ __forceinline__ void pool_item(const bf16* base, bf16* obase, int t0, int T) {
    constexpr int NR = 7 + 2 * HW;
    u32x4 rows[NR];
#pragma unroll
    for (int j = 0; j < NR; ++j) { const int tt = t0 - HW + j; rows[j] = (tt >= 0 && tt < T) ? *(const u32x4*)(base + (size_t)tt * DATT) : (u32x4){0u, 0u, 0u, 0u}; }
    float s[8];
#pragma unroll
    for (int i = 0; i < 8; ++i) s[i] = 0.f;
#define POOL_ADD(SGN, v_) { s[0] SGN bf_lo(v_.x); s[1] SGN bf_hi(v_.x); s[2] SGN bf_lo(v_.y); s[3] SGN bf_hi(v_.y); s[4] SGN bf_lo(v_.z); s[5] SGN bf_hi(v_.z); s[6] SGN bf_lo(v_.w); s[7] SGN bf_hi(v_.w); }
#pragma unroll
    for (int j = 0; j < 2 * HW; ++j) POOL_ADD(+=, rows[j])
#pragma unroll
    for (int i = 0; i < 8; ++i) {
        const int t = t0 + i, lo = max(t - HW, 0), hi = min(t + HW, T); const float ic = 1.0f / (float)(hi - lo); const u32x4 ov = rows[i + HW];
        u32x4 w; w.x = cvtpk(s[0] * ic - bf_lo(ov.x), s[1] * ic - bf_hi(ov.x)); w.y = cvtpk(s[2] * ic - bf_lo(ov.y), s[3] * ic - bf_hi(ov.y));
        w.z = cvtpk(s[4] * ic - bf_lo(ov.z), s[5] * ic - bf_hi(ov.z)); w.w = cvtpk(s[6] * ic - bf_lo(ov.w), s[7] * ic - bf_hi(ov.w));
        *(u32x4*)(obase + (size_t)t * DATT) = w;
        if (i < 7) { POOL_ADD(+=, rows[i + 2 * HW]) POOL_ADD(-=, rows[i]) }
    }
#undef POOL_ADD
}

namespace att {
constexpr int KSTRB = 272, VSTRB = 144, KBYTES = 64 * KSTRB, VBYTES = 128 * VSTRB, V_OFF = 2 * KBYTES, OX_OFF = 0;
static_assert(V_OFF + 3 * VBYTES <= 131072 && 65536 <= 131072, "attention LDS");
__device__ __forceinline__ int crow(int r, int hi) { return (r & 3) + 8 * (r >> 2) + 4 * hi; }
__device__ __forceinline__ void pv_tile(f32x16 (&o)[4], LAS unsigned char* vbase, const bf16x8 (&pb)[4]) {
#pragma unroll
    for (int ks = 0; ks < 4; ++ks) {
        bf16x8 vf[4];
#pragma unroll
        for (int d = 0; d < 4; ++d) vf[d] = *(const LAS bf16x8*)(vbase + d * 32 * VSTRB + ks * 32);
#pragma unroll
        for (int d = 0; d < 4; ++d) o[d] = __builtin_amdgcn_mfma_f32_32x32x16_bf16(vf[d], pb[ks], o[d], 0, 0, 0);
    }
}
__device__ __forceinline__ void unit(LAS unsigned char* lds, const bf16* Qp, const bf16* Kg, const bf16* Vtg, int tall, int nt, bf16* Op, float lam, const float* subg) {
    const int tid = threadIdx.x, lane = tid & 63, r = lane & 31, hi = lane >> 5, wid = __builtin_amdgcn_readfirstlane(tid >> 6), rg = wid & 3, mp = wid >> 2;
    bf16x8 qf[4];
    { const bf16* qp = Qp + (size_t)(rg * 32 + r) * DATT + mp * 64 + hi * 8;
#pragma unroll
      for (int s = 0; s < 4; ++s) qf[s] = *(const bf16x8*)(qp + 16 * s); }
    f32x16 o[4];
#pragma unroll
    for (int d = 0; d < 4; ++d)
#pragma unroll
        for (int i = 0; i < 16; ++i) o[d][i] = 0.f;
    float m_run = 0.f, l_run = 0.f;
    const bf16* ksrc[2]; const bf16* vsrc[2]; int kdst[2], vdst[2];
#pragma unroll
    for (int i = 0; i < 2; ++i) { const int id = tid + 512 * i; ksrc[i] = Kg + (size_t)(id >> 4) * DATT + (id & 15) * 8; kdst[i] = (id >> 4) * KSTRB + (id & 15) * 16;
        vsrc[i] = Vtg + (size_t)(id >> 3) * tall + (id & 7) * 8; vdst[i] = V_OFF + (id >> 3) * VSTRB + ((id & 7) >> 1) * 32 + (id & 1) * 8; }
    u32x4 kr[2], vr[2];
#pragma unroll
    for (int i = 0; i < 2; ++i) { kr[i] = *(const u32x4*)ksrc[i]; vr[i] = *(const u32x4*)vsrc[i]; }
#pragma unroll
    for (int i = 0; i < 2; ++i) { *(LAS u32x4*)(lds + kdst[i]) = kr[i]; *(LAS u32x2*)(lds + vdst[i]) = (u32x2){vr[i].x, vr[i].y}; *(LAS u32x2*)(lds + vdst[i] + 16) = (u32x2){vr[i].z, vr[i].w}; }
    __syncthreads();
    const int koff = r * KSTRB + (mp * 64 + hi * 8) * 2, voff = V_OFF + r * VSTRB + hi * 16;
    bf16x8 pb[4];
#pragma unroll
    for (int i = 0; i < 4; ++i) pb[i] = (bf16x8){0, 0, 0, 0, 0, 0, 0, 0};
    int vcur = 0, vprev = 0;
    for (int t = 0; t < nt; ++t) {
        const int kcur = (t & 1) * KBYTES, knxt = KBYTES - kcur, vnxt = (vcur == 2 * VBYTES) ? 0 : vcur + VBYTES;
        if (t + 1 < nt) {
#pragma unroll
            for (int i = 0; i < 2; ++i) { kr[i] = *(const u32x4*)(ksrc[i] + (size_t)(t + 1) * 64 * DATT); vr[i] = *(const u32x4*)(vsrc[i] + (t + 1) * 64); }
        }
        f32x16 p0, p1;
#define ATT_QK(C0) { _Pragma("unroll") for (int i = 0; i < 16; ++i) { p0[i] = 0.f; p1[i] = 0.f; } _Pragma("unroll") for (int s = 0; s < 4; ++s) { \
            const bf16x8 a0 = *(const LAS bf16x8*)(lds + kcur + koff + s * 32), a1 = *(const LAS bf16x8*)(lds + kcur + koff + 32 * KSTRB + s * 32); \
            p0 = __builtin_amdgcn_mfma_f32_32x32x16_bf16(a0, qf[s], p0, 0, 0, 0); p1 = __builtin_amdgcn_mfma_f32_32x32x16_bf16(a1, qf[s], p1, 0, 0, 0); } }
#define ATT_ROWMAX(mx) { mx = fmaxf(p0[0], p1[0]); _Pragma("unroll") for (int i = 1; i < 16; ++i) mx = fmaxf(mx, fmaxf(p0[i], p1[i])); mx = half_max(mx); }
        float rs;
        for (bool redo = false;;) {
            ATT_QK(0)
            if (t == 0 || redo) {
                float mx; ATT_ROWMAX(mx)
                if (t != 0) { mx = fmaxf(mx - m_run, 0.f); const float alpha = __builtin_amdgcn_exp2f(-mx); l_run *= alpha;
#pragma unroll
                    for (int d = 0; d < 4; ++d)
#pragma unroll
                        for (int i = 0; i < 16; ++i) o[d][i] *= alpha; }
                m_run += mx;
            }
            rs = 0.f;
#pragma unroll
            for (int i = 0; i < 16; ++i) { p0[i] = __builtin_amdgcn_exp2f(p0[i] - m_run); p1[i] = __builtin_amdgcn_exp2f(p1[i] - m_run); rs += p0[i] + p1[i]; }
            if (redo || !__any(!(rs < 1e18f))) break;
            redo = true;
        }
        l_run += rs;
#undef ATT_QK
#undef ATT_ROWMAX
#pragma unroll
        for (int s = 0; s < 2; ++s) {
            u32x4 w0, w1;
            w0.x = cvtpk(p0[8 * s + 0], p0[8 * s + 1]); w0.y = cvtpk(p0[8 * s + 2], p0[8 * s + 3]); w0.z = cvtpk(p0[8 * s + 4], p0[8 * s + 5]); w0.w = cvtpk(p0[8 * s + 6], p0[8 * s + 7]);
            w1.x = cvtpk(p1[8 * s + 0], p1[8 * s + 1]); w1.y = cvtpk(p1[8 * s + 2], p1[8 * s + 3]); w1.z = cvtpk(p1[8 * s + 4], p1[8 * s + 5]); w1.w = cvtpk(p1[8 * s + 6], p1[8 * s + 7]);
            pb[s] = __builtin_bit_cast(bf16x8, w0); pb[2 + s] = __builtin_bit_cast(bf16x8, w1);
        }
        pv_tile(o, lds + vcur + voff, pb);
        __builtin_amdgcn_iglp_opt(0);
        if (t + 1 < nt) {
#pragma unroll
            for (int i = 0; i < 2; ++i) { *(LAS u32x4*)(lds + knxt + kdst[i]) = kr[i]; *(LAS u32x2*)(lds + vnxt + vdst[i]) = (u32x2){vr[i].x, vr[i].y}; *(LAS u32x2*)(lds + vnxt + vdst[i] + 16) = (u32x2){vr[i].z, vr[i].w}; }
        }
        vprev = vcur; vcur = vnxt;
        __syncthreads();
    }
    __syncthreads();
    const float inv = 1.0f / half_sum(l_run);
    LAS float* ox = (LAS float*)(lds + OX_OFF) + rg * 4096 + lane;
    if (mp == 1) {
        const float f = inv * lam;
#pragma unroll
        for (int d = 0; d < 4; ++d)
#pragma unroll
            for (int i = 0; i < 16; ++i) ox[(d * 16 + i) * 64] = o[d][i] * f;
    }
    __syncthreads();
    if (mp == 0) {
        float ss = 0.f;
#pragma unroll
        for (int d = 0; d < 4; ++d)
#pragma unroll
            for (int i = 0; i < 16; ++i) { const float a = o[d][i] * inv - ox[(d * 16 + i) * 64]; o[d][i] = a; ss += a * a; }
        ss = half_sum(ss);
        const float rn = (1.0f / sqrtf(ss * (1.0f / 128.0f) + EPS)) * 0.8f;
        bf16* orow = Op + (size_t)(rg * 32 + r) * DM;
#pragma unroll
        for (int d = 0; d < 4; ++d)
#pragma unroll
            for (int g = 0; g < 4; ++g) { const int d0 = 32 * d + 8 * g + 4 * hi; const f32x4 gv = *(const f32x4*)(subg + d0);
                const f32x4 y = {o[d][4 * g] * rn * gv[0], o[d][4 * g + 1] * rn * gv[1], o[d][4 * g + 2] * rn * gv[2], o[d][4 * g + 3] * rn * gv[3]};
                *(u32x2*)(orow + d0) = pack4(y); }
    }
    __syncthreads();
}
}

constexpr int ARGS_OFF = 147200;
__device__ __forceinline__ void* ldarg(LAS unsigned char* lds, int i) {
    const unsigned long long v = ((const LAS unsigned long long*)(lds + ARGS_OFF))[i];
    const unsigned lo = __builtin_amdgcn_readfirstlane((unsigned)v), hi = __builtin_amdgcn_readfirstlane((unsigned)(v >> 32));
    return (void*)(__attribute__((address_space(1))) void*)(((unsigned long long)hi << 32) | lo);
}
#define LDARG(i) ldarg(lds, (i))
#define x_prompt ((const float*)LDARG(0))
#define x_sample ((const float*)LDARG(1))
#define cin ((const float*)LDARG(2))
#define cache_k ((const float*)LDARG(3))
#define cache_v ((const float*)LDARG(4))
#define c_ctx ((const float*)LDARG(5))
#define w_ada ((const float*)LDARG(6))
#define b_ada ((const float*)LDARG(7))
#define norm1_g ((const float*)LDARG(8))
#define w_in ((const float*)LDARG(9))
#define lam_q1 ((const float*)LDARG(10))
#define lam_k1 ((const float*)LDARG(11))
#define lam_q2 ((const float*)LDARG(12))
#define lam_k2 ((const float*)LDARG(13))
#define subln_g ((const float*)LDARG(14))
#define w_pool ((const float*)LDARG(15))
#define pool_scale ((const float*)LDARG(16))
#define w_out ((const float*)LDARG(17))
#define norm2_g ((const float*)LDARG(18))
#define w_up ((const float*)LDARG(19))
#define conv_k ((const float*)LDARG(20))
#define conv_b ((const float*)LDARG(21))
#define w_down ((const float*)LDARG(22))
#define norm_f_g ((const float*)LDARG(23))
#define out ((float*)LDARG(24))
#define ws ((unsigned char*)LDARG(25))
#define state_k (out + (size_t)MROWS * DM)
#define state_v (out + (size_t)MROWS * DM + (size_t)NCTX * DATT)
#define ctl ((unsigned*)(ws + WS_CTL))
#define mod ((float*)(ws + WS_MOD))
#define rope ((float*)(ws + WS_ROPE))
#define WinT ((bf16*)(ws + WS_WIN))
#define WoutT ((bf16*)(ws + WS_WOUT))
#define WupT ((bf16*)(ws + WS_WUP))
#define WdownT ((bf16*)(ws + WS_WDOWN))
#define WpoolT ((bf16*)(ws + WS_WPOOL))
#define Hb ((bf16*)(ws + WS_H))
#define Qb ((bf16*)(ws + WS_Q))
#define Kc ((bf16*)(ws + WS_KC))
#define Kl ((bf16*)(ws + WS_KL))
#define Vtc ((bf16*)(ws + WS_VTC))
#define Vtl ((bf16*)(ws + WS_VTL))
#define Pb ((bf16*)(ws + WS_P))
#define Pooled ((bf16*)(ws + WS_POOLED))
#define AM ((bf16*)(ws + WS_AM))
#define ACT ((bf16*)(ws + WS_ACT))
#define ebuf ((float*)(ws + WS_EBUF))
#define RLX_AGENT __ATOMIC_RELAXED, __HIP_MEMORY_SCOPE_AGENT
#define XB_TMO      128
#define XB_XCNT(j)  (256  + 64 * (j))
#define XB_XSUB(j)  (1280 + 64 * (j))
#define XB_XGEN(j)  (2304 + 64 * (j))
#define XB_TOP      3328
#define XB_TOPGEN   3392
#define XCD_BAR_WORDS 3456
#define XB_SPIN_CAP (1u << 18)

__device__ __forceinline__ unsigned xb_ld(unsigned* p)              { return __hip_atomic_load(p, __ATOMIC_RELAXED, __HIP_MEMORY_SCOPE_AGENT); }
__device__ __forceinline__ unsigned xb_add(unsigned* p, unsigned v) { return __hip_atomic_fetch_add(p, v, __ATOMIC_RELAXED, __HIP_MEMORY_SCOPE_AGENT); }
__device__ __forceinline__ unsigned xb_xcc_id() { return (unsigned)__builtin_amdgcn_s_getreg((3 << 11) | 20) & 0xFu; }
#define XB_SPIN(cond, bar) do { unsigned _sp = 0; while (cond) { __builtin_amdgcn_s_sleep(1); \
    if ((++_sp & 255u) == 0u) { if (xb_ld(&(bar)[XB_TMO])) break; if (_sp > XB_SPIN_CAP) { atomicAdd(&(bar)[XB_TMO], 1u); break; } } } } while (0)

struct XcdBarrier {
    unsigned* bar; unsigned x;
    volatile LAS unsigned* st;
};

__device__ __forceinline__ XcdBarrier xcd_barrier_post(unsigned* bar, volatile LAS unsigned* st) {
    XcdBarrier b; b.bar = bar; b.x = xb_xcc_id(); b.st = st;
    if (threadIdx.x == 0) (void)xb_add(&bar[XB_XCNT(b.x)], 1u);
    return b;
}
__device__ __forceinline__ void xcd_barrier_complete(unsigned* bar, unsigned x, unsigned& nloc, unsigned& nx) {
    const unsigned G = gridDim.x * gridDim.y * gridDim.z;
    unsigned sum, cnt, mine, sp = 0u;
    for (;;) {
        sum = 0u; cnt = 0u; mine = 0u;
#pragma unroll
        for (unsigned j = 0; j < 16; ++j) { const unsigned c = xb_ld(&bar[XB_XCNT(j)]); sum += c; cnt += (c > 0u) ? 1u : 0u; mine = (j == x) ? c : mine; }
        if (sum == G) break;
        __builtin_amdgcn_s_sleep(1);
        if ((++sp & 255u) == 0u) { if (xb_ld(&bar[XB_TMO])) break; if (sp > XB_SPIN_CAP) { atomicAdd(&bar[XB_TMO], 1u); break; } }
    }
    nloc = mine > 0u ? mine : 1u; nx = cnt > 0u ? cnt : 1u;
}

__device__ __forceinline__ void xcd_barrier(const XcdBarrier& b) {
    asm volatile("s_waitcnt vmcnt(0)" ::: "memory");
    __syncthreads();
    if (threadIdx.x == 0) {
        unsigned* bar = b.bar;
        __builtin_amdgcn_s_waitcnt(0);
        unsigned nloc = b.st[0], nx = b.st[1];
        if (nloc == 0u) { xcd_barrier_complete(bar, b.x, nloc, nx); b.st[0] = nloc; b.st[1] = nx; }
        const unsigned old = xb_add(&bar[XB_XSUB(b.x)], 1u);
        const unsigned gen = old / nloc;
        if (old + 1u == (gen + 1u) * nloc) {
            __builtin_amdgcn_fence(__ATOMIC_RELEASE, "agent");
            asm volatile("s_waitcnt vmcnt(0)" ::: "memory");
            const unsigned og = xb_add(&bar[XB_TOP], 1u);
            const unsigned tg = og / nx;
            if (og + 1u == (tg + 1u) * nx) xb_add(&bar[XB_TOPGEN], 1u);
            else XB_SPIN(xb_ld(&bar[XB_TOPGEN]) == tg, bar);
            __builtin_amdgcn_fence(__ATOMIC_ACQUIRE, "agent");
            xb_add(&bar[XB_XGEN(b.x)], 1u);
            asm volatile("s_waitcnt vmcnt(0)" ::: "memory");
        } else {
            XB_SPIN(xb_ld(&bar[XB_XGEN(b.x)]) == gen, bar);
            __builtin_amdgcn_fence(__ATOMIC_ACQUIRE, "agent");
            asm volatile("s_waitcnt vmcnt(0)" ::: "memory");
        }
    }
    __syncthreads();
}

constexpr int CW_BAR = 1024, MISC_OFF = 147416;
struct MidBar { LAS unsigned char* lds; int at;
    __device__ __forceinline__ void operator()(int ui) const { if (ui == at) { XcdBarrier b_; b_.bar = (unsigned*)((unsigned char*)ldarg(lds, 25) + WS_CTL) + CW_BAR; b_.x = xb_xcc_id(); b_.st = (volatile LAS unsigned*)(lds + MISC_OFF); xcd_barrier(b_); } } };
__global__ void __launch_bounds__(512, 2) fwd_kernel(Args args) {
    extern __shared__ __attribute__((aligned(16))) unsigned char lds_raw[];
    LAS unsigned char* lds = (LAS unsigned char*)lds_raw;
    cg::grid_group grid = cg::this_grid();
    const int tid = threadIdx.x, lane = tid & 63, wave = __builtin_amdgcn_readfirstlane(tid >> 6);
    const int G = gridDim.x, bx = blockIdx.x;
    const int vcu = (G % 8 == 0) ? (bx % 8) * (G / 8) + bx / 8 : bx;
    const int gw = vcu * 8 + wave, NGW = G * 8;
    const int gt = bx * 512 + tid, GT = G * 512;
    if (tid == 0) { LAS unsigned long long* ap = (LAS unsigned long long*)(lds + ARGS_OFF);
        ap[0] = (unsigned long long)args.in[0];
        ap[1] = (unsigned long long)args.in[1];
        ap[2] = (unsigned long long)args.in[2];
        ap[3] = (unsigned long long)args.in[3];
        ap[4] = (unsigned long long)args.in[4];
        ap[5] = (unsigned long long)args.in[5];
        ap[6] = (unsigned long long)args.in[6];
        ap[7] = (unsigned long long)args.in[7];
        ap[8] = (unsigned long long)args.in[8];
        ap[9] = (unsigned long long)args.in[9];
        ap[10] = (unsigned long long)args.in[10];
        ap[11] = (unsigned long long)args.in[11];
        ap[12] = (unsigned long long)args.in[12];
        ap[13] = (unsigned long long)args.in[13];
        ap[14] = (unsigned long long)args.in[14];
        ap[15] = (unsigned long long)args.in[15];
        ap[16] = (unsigned long long)args.in[16];
        ap[17] = (unsigned long long)args.in[17];
        ap[18] = (unsigned long long)args.in[18];
        ap[19] = (unsigned long long)args.in[19];
        ap[20] = (unsigned long long)args.in[20];
        ap[21] = (unsigned long long)args.in[21];
        ap[22] = (unsigned long long)args.in[22];
        ap[23] = (unsigned long long)args.in[23];
        ap[24] = (unsigned long long)args.outp; ap[25] = (unsigned long long)args.wsp;
        ((LAS unsigned*)(lds + MISC_OFF))[0] = 0u; ((LAS unsigned*)(lds + MISC_OFF))[1] = 0u; }
    __syncthreads();
    { XcdBarrier b0_ = xcd_barrier_post(ctl + CW_BAR, (volatile LAS unsigned*)(lds + MISC_OFF)); (void)b0_; }
#define GRID_BAR() do { XcdBarrier b_; b_.bar = ctl + CW_BAR; b_.x = xb_xcc_id(); b_.st = (volatile LAS unsigned*)(lds + MISC_OFF); xcd_barrier(b_); } while (0)

#if PH0
    if (bx == G - 1) {
        for (int e = tid; e < 1024; e += 512) { const int pos = e >> 4, f = e & 15; const float inv = exp2f(-(float)f * (13.287712379549449f / 16.0f)); const float a = (float)pos * inv; float sn, cs; sincosf(a, &sn, &cs); rope[2 * e] = cs; rope[2 * e + 1] = sn; }
    }
    for (int j = bx; j < 128; j += G) {
        LAS float* scond = (LAS float*)lds; LAS float* red = (LAS float*)(lds + 73728);
        for (int e = tid; e < 9 * DM; e += 512) { const int b = e >> 11, k = e & 2047; const float v = (b < 8) ? cin[b * DM + k] : c_ctx[k]; scond[e] = v / (1.0f + expf(-v)); }
        __syncthreads();
        const int cgp = tid % 24, kl = tid / 24;
        f32x4 acc[9];
#pragma unroll
        for (int b = 0; b < 9; ++b) acc[b] = (f32x4){0.f, 0.f, 0.f, 0.f};
        if (kl < 21) {
            const float* wp = w_ada + 96 * j + 4 * cgp;
#pragma unroll 4
            for (int k = kl; k < DM; k += 21) { const f32x4 w = *(const f32x4*)(wp + (size_t)k * NMOD);
#pragma unroll
                for (int b = 0; b < 9; ++b) acc[b] += w * scond[b * DM + k]; }
#pragma unroll
            for (int b = 0; b < 9; ++b) *(LAS f32x4*)(red + (kl * 9 + b) * 96 + 4 * cgp) = acc[b];
        }
        __syncthreads();
        for (int e = tid; e < 9 * 96; e += 512) { const int b = e / 96, c = e % 96; float s = b_ada[96 * j + c];
            for (int q = 0; q < 21; ++q) s += red[(q * 9 + b) * 96 + c];
            mod[b * NMOD + 96 * j + c] = s; }
        __syncthreads();
    }
    {
        LAS float* scr = (LAS float*)(lds + wave * 8448);
        volatile LAS int* qb = (volatile LAS int*)(lds + MISC_OFF + 12);
        const int n_items = (G == 256 ? IT_TOTAL - IT_WDOWN - IT_WOUT : IT_TOTAL);
        for (int base = 0, sub = 8;;) {
            if (sub == 8) {
                __syncthreads();
                if (tid == 0) qb[0] = (int)atomicAdd(ctl, 64u);
                __syncthreads();
                base = qb[0]; sub = 0;
                if (base >= n_items) break;
            }
            const int it = base + wave * 8 + sub; ++sub;
            if (it >= n_items) continue;
            int r_ = it;
            if (r_ < IT_WIN) { const int nb = DIN / 32; transpose_item(w_in, DIN, 64 * (r_ / nb), 32 * (r_ % nb), WinT, DM, 32 * (r_ % nb), scr, lane); continue; } r_ -= IT_WIN;
            if (r_ < IT_WUP) { const int nb = NUP / 32; const int n0 = 32 * (r_ % nb); const int drow = n0 < DFF ? (n0 / 128) * 256 + (n0 % 128) : ((n0 - DFF) / 128) * 256 + 128 + ((n0 - DFF) % 128);
                transpose_item(w_up, NUP, 64 * (r_ / nb), n0, WupT, DM, drow, scr, lane); continue; } r_ -= IT_WUP;
            if (r_ < IT_WPOOL) { const int g = r_ >> 5, q = r_ & 31; transpose_item(w_pool + (size_t)g * 65536, 256, 64 * (q >> 3), 32 * (q & 7), WpoolT + (size_t)g * 65536, 256, 32 * (q & 7), scr, lane); continue; } r_ -= IT_WPOOL;
            if (r_ < IT_CV) { const int b = r_ >> 8, q = r_ & 255;
                transpose_item(cache_v + (size_t)b * PAST * DATT, DATT, 64 * (q >> 5), 32 * (q & 31), Vtl + (size_t)b * DATT * TALL, TALL, 32 * (q & 31), scr, lane); continue; } r_ -= IT_CV;
            if (r_ >= IT_CK) { r_ -= IT_CK; const int nb = DM / 32;
                if (r_ < IT_WOUT) transpose_item(w_out, DM, 64 * (r_ / nb), 32 * (r_ % nb), WoutT, DM, 32 * (r_ % nb), scr, lane);
                else { r_ -= IT_WOUT; transpose_item(w_down, DM, 64 * (r_ / nb), 32 * (r_ % nb), WdownT, DFF, 32 * (r_ % nb), scr, lane); }
                continue; }
            { const int b = r_ >> 9, key = r_ & 511; const f32x4* src = (const f32x4*)(cache_k + ((size_t)b * PAST + key) * DATT); bf16* dst = Kl + ((size_t)b * TALL + key) * DATT;
#pragma unroll
              for (int j = 0; j < 4; ++j) *(u32x2*)(dst + 4 * lane + 256 * j) = pack4(src[lane + 64 * j]); }
        }
    }
#endif
    grid.sync();
#if PH1
    for (int row = gw; row < MROWS; row += NGW) {
        const float* xr = row < NCTX ? x_prompt + (size_t)row * DM : x_sample + (size_t)(row - NCTX) * DM; const int bidx = row < NCTX ? 8 : (row - NCTX) >> 11;
        norm_row(xr, norm1_g, mod + (size_t)bidx * NMOD + DM, mod + (size_t)bidx * NMOD, Hb + (size_t)row * DM, nullptr, lane);
    }
#endif
    GRID_BAR();
#if PH2
    {
        pg8::Gemm g{Hb, WinT, DM, DM, DM, 0}; pg8::StaticOrder S; S.init(MROWS, DIN, G, bx);
        pg8::EpiInProj E{Qb, Kc, Kl, Vtc, Vtl, Pb, state_k, state_v, rope};
        pg8::gemm_phase<pg8::EpiInProj, pg8::StaticOrder, true, true>(lds, g, S, E);
    }
#endif
    GRID_BAR();
#if PH3
    for (int item = gt; item < (MROWS / 8) * 128; item += GT) {
        const int g = (item >> 6) & 3, rb8 = (item >> 8) * 2 + ((item >> 5) & 1), c8 = g * 32 + (item & 31);
        const int row0 = rb8 * 8;
        const int T = row0 < NCTX ? TCTX : TLAT, t0 = row0 < NCTX ? (row0 & (TCTX - 1)) : ((row0 - NCTX) & (TLAT - 1));
        const bf16* base = Pb + (size_t)(row0 - t0) * DATT + c8 * 8; bf16* obase = Pooled + (size_t)(row0 - t0) * DATT + c8 * 8;
        if (g == 0) pool_item<1>(base, obase, t0, T); else if (g == 1) pool_item<2>(base, obase, t0, T); else if (g == 2) pool_item<4>(base, obase, t0, T); else pool_item<8>(base, obase, t0, T);
    }
    {
        const float s1 = wave_sum(lam_q1[lane] * lam_k1[lane]), s2 = wave_sum(lam_q2[lane] * lam_k2[lane]);
        const float lam = expf(s1) - expf(s2) + 0.2f;
        const int per = (1024 + G - 1) / G;
        for (int i = 0; i < per; ++i) { const int idx = vcu * per + i; if (idx >= 1024) break;
            const int b = idx >> 7, h = (idx >> 4) & 7, qb = idx & 15; const size_t qrow0 = (size_t)NCTX + (size_t)b * TLAT + qb * 128;
            att::unit(lds, Qb + qrow0 * DATT + h * 128, Kl + (size_t)b * TALL * DATT + h * 128, Vtl + (size_t)(b * 8 + h) * 128 * TALL, TALL, TALL / 64, AM + qrow0 * DM + h * 128, lam, subln_g); }
        for (int idx = vcu; idx < 256; idx += G) {
            const int b = idx >> 4, h = (idx >> 1) & 7, qb = idx & 1; const size_t qrow0 = (size_t)b * TCTX + qb * 128;
            att::unit(lds, Qb + qrow0 * DATT + h * 128, Kc + (size_t)b * TCTX * DATT + h * 128, Vtc + (size_t)(b * 8 + h) * 128 * TCTX, TCTX, TCTX / 64, AM + qrow0 * DM + h * 128, lam, subln_g); }
    }
#endif
    GRID_BAR();
#if PH3B
    {
        int kp = 256; asm volatile("" : "+s"(kp));
        pg8::Gemm g{Pooled, WpoolT, DATT, 256, kp, 256}; pg8::StaticOrder S; S.init(MROWS, DATT, G, bx);
        pg8::EpiPool E{AM, pool_scale};
        pg8::gemm_phase<pg8::EpiPool, pg8::StaticOrder, true, true>(lds, g, S, E);
        if (gridDim.x == 256 && blockIdx.x >= 64) {
            int t_ = threadIdx.x; asm volatile("" : "+v"(t_));
            const int ln_ = t_ & 63, wv_ = __builtin_amdgcn_readfirstlane(t_ >> 6);
            LAS float* scr = (LAS float*)(lds + wv_ * 8448);
            for (int it = ((int)blockIdx.x - 64) * 8 + wv_; it < IT_WOUT; it += 192 * 8) transpose_item(w_out, DM, 64 * (it >> 6), 32 * (it & 63), WoutT, DM, 32 * (it & 63), scr, ln_);
        }
    }
#endif
    GRID_BAR();
#if PH4
    {
        pg8::Gemm g{AM, WoutT, DM, DM, DM, 0}; pg8::PanelOrder S; S.init(MROWS, DM, G, bx);
        pg8::EpiGateBf16 E{Hb, mod + 2 * DM};
        MidBar MB{lds, S.fast ? 1 : -1};
        pg8::gemm_phase<pg8::EpiGateBf16, pg8::PanelOrder, true, true, MidBar>(lds, g, S, E, MB);
#define P5_ROW(row) { const int bidx = (row) < NCTX ? 8 : ((row) - NCTX) >> 11; const float* xr = (row) < NCTX ? x_prompt + (size_t)(row) * DM : x_sample + (size_t)((row) - NCTX) * DM; \
        norm_row(xr, norm2_g, mod + (size_t)bidx * NMOD + 4 * DM, mod + (size_t)bidx * NMOD + 3 * DM, AM + (size_t)(row) * DM, nullptr, lane, Hb + (size_t)(row) * DM, nullptr); }
        if (S.fast && bx >= 128) {
            for (int row = (bx - 128) * 8 + wave; row < 64 * 256; row += 1024) P5_ROW(row)
        }
    }
#endif
    GRID_BAR();
#if PH5
    for (int row = (G == 256 ? 64 * 256 : 0) + gw; row < MROWS; row += NGW) P5_ROW(row)
#undef P5_ROW
#endif
    GRID_BAR();
#if PH6
    {
        pg8::Gemm g{AM, WupT, DM, DM, DM, 0}; pg8::StaticOrder S; S.init(MROWS, NUP, G, bx);
        pg8::EpiUp E{ACT, ebuf, conv_k, conv_b, (LAS float*)(lds + XL_OFF)};
        pg8::gemm_phase<pg8::EpiUp, pg8::StaticOrder, true, true>(lds, g, S, E);
        if (gridDim.x == 256 && blockIdx.x >= 112) {
            int t_ = threadIdx.x; asm volatile("" : "+v"(t_));
            const int ln_ = t_ & 63, wv_ = __builtin_amdgcn_readfirstlane(t_ >> 6);
            LAS float* scr = (LAS float*)(lds + wv_ * 8448);
            for (int it = ((int)blockIdx.x - 112) * 8 + wv_; it < IT_WDOWN; it += 144 * 8) transpose_item(w_down, DM, 64 * (it >> 6), 32 * (it & 63), WdownT, DFF, 32 * (it & 63), scr, ln_);
        }
    }
#endif
    GRID_BAR();
#if PH7
    for (int item = gt; item < 56 * DFF; item += GT) {
        const int bnd = item / DFF, j = item % DFF; const int pmA = 16 + (bnd / 7) * 8 + (bnd % 7), pmB = pmA + 1;
        const int tcg = (j >> 7) * 256 + (j & 127), tcv = tcg + 128;
        const float* eA = ebuf + (size_t)pmA * 4 * NUP; const float* eB = ebuf + (size_t)pmB * 4 * NUP;
        const float g254 = eA[2 * NUP + tcg], g255 = eA[3 * NUP + tcg], g0 = eB[tcg], g1 = eB[NUP + tcg];
        const float v254 = eA[2 * NUP + tcv], v255 = eA[3 * NUP + tcv], v0 = eB[tcv], v1 = eB[NUP + tcv];
        const float k0g = conv_k[j], k1g = conv_k[NUP + j], k2g = conv_k[2 * NUP + j], bg = conv_b[j];
        const float k0v = conv_k[DFF + j], k1v = conv_k[NUP + DFF + j], k2v = conv_k[2 * NUP + DFF + j], bv = conv_b[DFF + j];
        const float ga = k0g * g254 + k1g * g255 + k2g * g0 + bg, va = k0v * v254 + k1v * v255 + k2v * v0 + bv;
        const float gb = k0g * g255 + k1g * g0 + k2g * g1 + bg, vb = k0v * v255 + k1v * v0 + k2v * v1 + bv;
        ACT[((size_t)pmA * 256 + 255) * DFF + j] = pg8::bf1(ga / (1.0f + __expf(-ga)) * va);
        ACT[((size_t)pmB * 256) * DFF + j] = pg8::bf1(gb / (1.0f + __expf(-gb)) * vb);
    }
#endif
    GRID_BAR();
#if PH8
    {
        pg8::Gemm g{ACT, WdownT, DFF, DFF, DFF, 0}; pg8::PanelOrder S; S.init(MROWS, DM, G, bx);
        pg8::EpiGateBf16 E{AM, mod + 5 * DM};
        MidBar MB{lds, S.fast ? 1 : -1};
        pg8::gemm_phase<pg8::EpiGateBf16, pg8::PanelOrder, true, true, MidBar>(lds, g, S, E, MB);
#define P9_ROW(row) { const float* xr = (row) < NCTX ? x_prompt + (size_t)(row) * DM : x_sample + (size_t)((row) - NCTX) * DM; \
        norm_row(xr, norm_f_g, nullptr, nullptr, nullptr, out + (size_t)(row) * DM, lane, Hb + (size_t)(row) * DM, AM + (size_t)(row) * DM); }
        if (S.fast && bx >= 128) {
            for (int row = (bx - 128) * 8 + wave; row < 64 * 256; row += 1024) P9_ROW(row)
        }
    }
#endif
    GRID_BAR();
#if PH9
    for (int row = (G == 256 ? 64 * 256 : 0) + gw; row < MROWS; row += NGW) P9_ROW(row)
#undef P9_ROW
#endif

}

#undef x_prompt
#undef x_sample
#undef cin
#undef cache_k
#undef cache_v
#undef c_ctx
#undef w_ada
#undef b_ada
#undef norm1_g
#undef w_in
#undef lam_q1
#undef lam_k1
#undef lam_q2
#undef lam_k2
#undef subln_g
#undef w_pool
#undef pool_scale
#undef w_out
#undef norm2_g
#undef w_up
#undef conv_k
#undef conv_b
#undef w_down
#undef norm_f_g
#undef out
#undef ws
#undef state_k
#undef state_v
#undef ctl
#undef mod
#undef rope
#undef WinT
#undef WoutT
#undef WupT
#undef WdownT
#undef WpoolT
#undef Hb
#undef Qb
#undef Kc
#undef Kl
#undef Vtc
#undef Vtl
#undef Pb
#undef Pooled
#undef AM
#undef ACT
#undef ebuf
extern "C" void kernel_launch(void* const* d_in, const int* in_sizes, int n_in, void* d_out, int out_size, void* d_ws, size_t ws_size, hipStream_t stream) {
    static int grid = 0;
    if (grid == 0) {
        if (n_in != 24 || ws_size < WS_END) { fprintf(stderr, "kernel_launch: unexpected n_in %d / ws_size %zu\n", n_in, ws_size); grid = -1; return; }
        int dev = 0, cus = 0, per_cu = 0;
        (void)hipGetDevice(&dev); (void)hipDeviceGetAttribute(&cus, hipDeviceAttributeMultiprocessorCount, dev);
        (void)hipFuncSetAttribute((const void*)fwd_kernel, hipFuncAttributeMaxDynamicSharedMemorySize, LDS_BYTES);
        (void)hipOccupancyMaxActiveBlocksPerMultiprocessor(&per_cu, (const void*)fwd_kernel, 512, LDS_BYTES);
        if (per_cu < 1) { fprintf(stderr, "kernel_launch: occupancy query returned %d\n", per_cu); per_cu = 1; }
        (void)hipGetLastError();
        grid = cus * 1;
    }
    if (grid < 0) return;
    (void)hipMemsetAsync((char*)d_ws + WS_CTL, 0, CTL_ZERO_BYTES, stream);
    Args a{};
    for (int i = 0; i < 24; ++i) a.in[i] = (const float*)d_in[i];
    a.outp = (float*)d_out; a.wsp = (unsigned char*)d_ws;
    void* kargs[] = {&a};
    hipError_t e = hipLaunchCooperativeKernel((const void*)fwd_kernel, dim3(grid), dim3(512), kargs, LDS_BYTES, stream);
    if (e != hipSuccess) fprintf(stderr, "kernel_launch: cooperative launch failed: %s (grid %d)\n", hipGetErrorString(e), grid);
}
```
